# Optimizing an MI355X kernel written in HIP

```python
import jax, jax.numpy as jnp
from jax import lax
import numpy as np

D_MODEL = 1024
BATCH = 4
SEQ = 8192
DEPTH = 2

GRID_W = 64
CTX_LEN = 256
GLA_HEADS = 4
GLA_DK = 48
GLA_DV = 96
GLA_RANK = 16
GLA_TAU = 16.0
GLA_CHUNK = 64
SWA_HEADS = 6
SWA_KV_HEADS = 2
HEAD_DIM = 64
WINDOW = 128
Q_BLOCK = 128
ROPE_BASE = 10000.0
POOL_WINDOWS = (2, 4, 8, 16)
POOL_GROUP = 64
D_FF = 2816
CONV_W = 3
EPS = 1e-6
NEG_INF = -1e30

GLA_QK = GLA_HEADS * GLA_DK
GLA_V = GLA_HEADS * GLA_DV
SWA_Q = SWA_HEADS * HEAD_DIM
SWA_KV = SWA_KV_HEADS * HEAD_DIM
POOL_W = len(POOL_WINDOWS) * POOL_GROUP
MIX_W = GLA_V + SWA_Q + POOL_W
IN_SPLITS = (GLA_QK, GLA_QK, GLA_V, GLA_V, GLA_RANK, GLA_RANK, SWA_Q, SWA_KV, SWA_KV, POOL_W)
IN_W = GLA_QK * 2 + GLA_V * 2 + GLA_RANK * 2 + SWA_Q + SWA_KV * 2 + POOL_W

kernel_name = 'hybrid_gla_swa_pool_prefix_dit'

F32 = jnp.float32


def rms_norm(x, g):
    xf = x.astype(F32)
    y = xf * lax.rsqrt(jnp.mean(xf * xf, axis=-1, keepdims=True) + EPS)
    return (y * g.astype(F32)).astype(x.dtype)


def heads(t, n):
    return t.reshape(t.shape[:-1] + (n, t.shape[-1] // n))


def flip(t):
    return jnp.flip(t, axis=1)


def in_proj_split(p):
    offs, acc = [], 0
    for w in IN_SPLITS[:-1]:
        acc += w
        offs.append(acc)
    return jnp.split(p, offs, axis=-1)


def rope_2d_tables(n_tokens):
    rows_n = n_tokens // GRID_W
    rows = jnp.repeat(jnp.arange(rows_n), GRID_W).astype(F32)
    cols = jnp.tile(jnp.arange(GRID_W), rows_n).astype(F32)
    nf = HEAD_DIM // 4
    inv = ROPE_BASE ** (-jnp.arange(nf, dtype=F32) / nf)
    ang = jnp.concatenate([rows[:, None] * inv, cols[:, None] * inv], axis=-1)
    return jnp.cos(ang), jnp.sin(ang)


def apply_rope_2d(x, cos, sin):
    xf = x.astype(F32)
    nf = HEAD_DIM // 4
    cos = cos[:, None, :]
    sin = sin[:, None, :]
    outs = []
    for a in range(2):
        xa = xf[..., a * 2 * nf:(a + 1) * 2 * nf]
        x1, x2 = xa[..., :nf], xa[..., nf:]
        ca, sa = cos[..., a * nf:(a + 1) * nf], sin[..., a * nf:(a + 1) * nf]
        outs += [x1 * ca - x2 * sa, x2 * ca + x1 * sa]
    return jnp.concatenate(outs, axis=-1).astype(x.dtype)


def gla_log_decay(z, w_dec, b_dec):
    la = jax.nn.log_sigmoid(z.astype(F32) @ w_dec.astype(F32) + b_dec.astype(F32)) / GLA_TAU
    return heads(la, GLA_HEADS)


def gla_chunked(q, k, v, log_a, s0):
    B, T, H, DK = q.shape
    DV = v.shape[-1]
    C = GLA_CHUNK
    N = T // C
    qc = q.astype(F32).reshape(B, N, C, H, DK)
    kc = k.astype(F32).reshape(B, N, C, H, DK)
    vc = v.astype(F32).reshape(B, N, C, H, DV)
    bc = jnp.cumsum(log_a.astype(F32).reshape(B, N, C, H, DK), axis=2)
    b_last = bc[:, :, -1:]
    q_dec = qc * jnp.exp(bc)
    k_inv = kc * jnp.exp(-bc)
    k_end = kc * jnp.exp(b_last - bc)
    scores = jnp.einsum('bnihd,bnjhd->bnhij', q_dec, k_inv)
    lower = jnp.tril(jnp.ones((C, C), dtype=bool))
    scores = jnp.where(lower, scores, 0.0)
    o_intra = jnp.einsum('bnhij,bnjhv->bnihv', scores, vc)
    chunk_state = jnp.einsum('bnjhd,bnjhv->nbhdv', k_end, vc)
    chunk_decay = jnp.transpose(jnp.exp(b_last[:, :, 0]), (1, 0, 2, 3))

    def step(s, inp):
        dec, upd = inp
        return dec[..., None] * s + upd, s

    s_final, s_init = lax.scan(step, s0.astype(F32), (chunk_decay, chunk_state))
    o_inter = jnp.einsum('bnihd,nbhdv->bnihv', q_dec, s_init)
    return (o_intra + o_inter).reshape(B, T, H, DV), s_final


def gla_final_state(k, v, log_a):
    b = jnp.cumsum(log_a.astype(F32), axis=1)
    w = jnp.exp(b[:, -1:] - b)
    return jnp.einsum('bthd,bthv->bhdv', k.astype(F32) * w, v.astype(F32))


def gla_output(o, g, norm_g):
    o = rms_norm(o, norm_g)
    B, T = o.shape[:2]
    return (o.reshape(B, T, -1) * jax.nn.silu(g.astype(F32))).astype(g.dtype)


def window_attention(q, k, v, k_ctx, v_ctx, sink):
    B, S, HQ, D = q.shape
    KV = k.shape[2]
    G = HQ // KV
    N = S // Q_BLOCK
    qb = q.astype(F32).reshape(B, N, Q_BLOCK, KV, G, D)
    pad = ((0, 0), (Q_BLOCK, Q_BLOCK), (0, 0), (0, 0))
    kp = jnp.pad(k.astype(F32), pad).reshape(B, N + 2, Q_BLOCK, KV, D)
    vp = jnp.pad(v.astype(F32), pad).reshape(B, N + 2, Q_BLOCK, KV, D)
    kb = jnp.concatenate([kp[:, :-2], kp[:, 1:-1], kp[:, 2:]], axis=2)
    vb = jnp.concatenate([vp[:, :-2], vp[:, 1:-1], vp[:, 2:]], axis=2)
    q_pos = jnp.arange(S).reshape(N, Q_BLOCK)
    k_pos = (jnp.arange(N)[:, None] - 1) * Q_BLOCK + jnp.arange(3 * Q_BLOCK)[None, :]
    dist = q_pos[:, :, None] - k_pos[:, None, :]
    valid = (jnp.abs(dist) <= WINDOW) & (k_pos[:, None, :] >= 0) & (k_pos[:, None, :] < S)
    scale = D ** -0.5
    s_loc = jnp.einsum('bnqkgd,bnjkd->bnkgqj', qb, kb) * scale
    s_loc = jnp.where(valid[None, :, None, None], s_loc, NEG_INF)
    s_ctx = jnp.einsum('bnqkgd,bckd->bnkgqc', qb, k_ctx.astype(F32)) * scale
    s_sink = jnp.broadcast_to(sink.astype(F32).reshape(KV, G)[None, None, :, :, None, None],
                              (B, N, KV, G, Q_BLOCK, 1))
    p = jax.nn.softmax(jnp.concatenate([s_loc, s_ctx, s_sink], axis=-1), axis=-1)
    n_loc = 3 * Q_BLOCK
    n_ctx = k_ctx.shape[1]
    o = (jnp.einsum('bnkgqj,bnjkd->bnqkgd', p[..., :n_loc], vb)
         + jnp.einsum('bnkgqc,bckd->bnqkgd', p[..., n_loc:n_loc + n_ctx], v_ctx.astype(F32)))
    return o.reshape(B, S, HQ * D).astype(q.dtype)


def context_attention(q, k, v, sink):
    B, L, HQ, D = q.shape
    KV = k.shape[2]
    G = HQ // KV
    qg = q.astype(F32).reshape(B, L, KV, G, D)
    s = jnp.einsum('blkgd,bckd->bkglc', qg, k.astype(F32)) * D ** -0.5
    s_sink = jnp.broadcast_to(sink.astype(F32).reshape(KV, G)[None, :, :, None, None], (B, KV, G, L, 1))
    p = jax.nn.softmax(jnp.concatenate([s, s_sink], axis=-1), axis=-1)
    o = jnp.einsum('bkglc,bckd->blkgd', p[..., :L], v.astype(F32))
    return o.reshape(B, L, HQ * D).astype(q.dtype)


def multiscale_pool(u, pool_w, pool_scale):
    T = u.shape[1]
    uf = u.astype(F32)
    prefix = jnp.pad(jnp.cumsum(uf, axis=1), ((0, 0), (1, 0), (0, 0)))
    t = jnp.arange(T)
    outs = []
    for g, w in enumerate(POOL_WINDOWS):
        lo = jnp.clip(t - w // 2, 0, T)
        hi = jnp.clip(t + w // 2, 0, T)
        sl = slice(g * POOL_GROUP, (g + 1) * POOL_GROUP)
        pg = prefix[:, :, sl]
        mean = (pg[:, hi] - pg[:, lo]) / (hi - lo).astype(F32)[None, :, None]
        outs.append((mean - uf[:, :, sl]) @ pool_w[g].astype(F32))
    y = jnp.concatenate(outs, axis=-1) * pool_scale.astype(F32)
    return y.astype(u.dtype)


def conv_ffn(h, w_up, conv_w, conv_b, w_down):
    u = h @ w_up
    up = jnp.pad(u, ((0, 0), (1, 1), (0, 0)))
    u = up[:, :-2] * conv_w[0] + up[:, 1:-1] * conv_w[1] + up[:, 2:] * conv_w[2] + conv_b
    a, g = jnp.split(u, 2, axis=-1)
    return (jax.nn.silu(g) * a) @ w_down


def hybrid_layer(x, ctx, mod, modc, norm1_g, w_in, gla_w_dec, gla_b_dec, gla_norm_g, q_norm_g,
                 k_norm_g, sink_logit, pool_w, pool_scale, w_out, norm2_g, w_up, conv_w, conv_b,
                 w_down, cos, sin, update_ctx):
    sh1, sc1, g1, sh2, sc2, g2 = jnp.split(mod, 6, axis=-1)
    csh1, csc1, cg1, csh2, csc2, cg2 = jnp.split(modc, 6, axis=-1)
    h = rms_norm(x, norm1_g) * (1 + sc1) + sh1
    hc = rms_norm(ctx, norm1_g) * (1 + csc1) + csh1
    gq, gk, gv, gg, zf, zb, aq, ak, av, pu = in_proj_split(h @ w_in)
    cgq, cgk, cgv, cgg, czf, czb, caq, cak, cav, cpu = in_proj_split(hc @ w_in)

    la_f = gla_log_decay(zf, gla_w_dec[0], gla_b_dec[0])
    la_b = gla_log_decay(zb, gla_w_dec[1], gla_b_dec[1])
    cla_f = gla_log_decay(czf, gla_w_dec[0], gla_b_dec[0])
    cla_b = gla_log_decay(czb, gla_w_dec[1], gla_b_dec[1])
    q = heads(gq, GLA_HEADS) * GLA_DK ** -0.5
    k = heads(gk, GLA_HEADS)
    v = heads(gv, GLA_HEADS)
    ck = heads(cgk, GLA_HEADS)
    cv = heads(cgv, GLA_HEADS)
    if update_ctx:
        cq = heads(cgq, GLA_HEADS) * GLA_DK ** -0.5
        s0 = jnp.zeros((ctx.shape[0], GLA_HEADS, GLA_DK, GLA_DV), F32)
        oc_f, st_f = gla_chunked(cq, ck, cv, cla_f, s0)
        oc_b, st_b = gla_chunked(flip(cq), flip(ck), flip(cv), flip(cla_b), s0)
        gla_ctx = gla_output(oc_f + flip(oc_b), cgg, gla_norm_g)
    else:
        st_f = gla_final_state(ck, cv, cla_f)
        st_b = gla_final_state(flip(ck), flip(cv), flip(cla_b))
    o_f, _ = gla_chunked(q, k, v, la_f, st_f)
    o_b, _ = gla_chunked(flip(q), flip(k), flip(v), flip(la_b), st_b)
    gla_lat = gla_output(o_f + flip(o_b), gg, gla_norm_g)

    aqh = apply_rope_2d(rms_norm(heads(aq, SWA_HEADS), q_norm_g), cos, sin)
    akh = apply_rope_2d(rms_norm(heads(ak, SWA_KV_HEADS), k_norm_g), cos, sin)
    avh = heads(av, SWA_KV_HEADS)
    cakh = rms_norm(heads(cak, SWA_KV_HEADS), k_norm_g)
    cavh = heads(cav, SWA_KV_HEADS)
    swa_lat = window_attention(aqh, akh, avh, cakh, cavh, sink_logit)

    pool_lat = multiscale_pool(pu, pool_w, pool_scale)

    y = jnp.concatenate([gla_lat, swa_lat, pool_lat], axis=-1) @ w_out
    x = x + g1 * y
    h2 = rms_norm(x, norm2_g) * (1 + sc2) + sh2
    x = x + g2 * conv_ffn(h2, w_up, conv_w, conv_b, w_down)

    if update_ctx:
        swa_ctx = context_attention(rms_norm(heads(caq, SWA_HEADS), q_norm_g), cakh, cavh, sink_logit)
        pool_ctx = multiscale_pool(cpu, pool_w, pool_scale)
        yc = jnp.concatenate([gla_ctx, swa_ctx, pool_ctx], axis=-1) @ w_out
        ctx = ctx + cg1 * yc
        hc2 = rms_norm(ctx, norm2_g) * (1 + csc2) + csh2
        ctx = ctx + cg2 * conv_ffn(hc2, w_up, conv_w, conv_b, w_down)
    return x, ctx


def setup_inputs(seed: int = 0) -> dict:
    key = jax.random.key(seed)
    ks = jax.random.split(key, 24)
    D = D_MODEL
    nrm = lambda k, shape: jax.random.normal(k, shape, F32)
    return {
        'x': nrm(ks[0], (BATCH, SEQ, D)),
        'c': nrm(ks[1], (BATCH, D)),
        'ctx': nrm(ks[2], (BATCH, CTX_LEN, D)),
        'c_ctx': nrm(ks[3], (D,)),
        'w_ada': nrm(ks[4], (DEPTH, D, 6 * D)) * (0.5 * D ** -0.5),
        'b_ada': nrm(ks[5], (DEPTH, 6 * D)) * 0.02,
        'norm1_g': 1.0 + 0.02 * nrm(ks[6], (DEPTH, D)),
        'w_in': nrm(ks[7], (DEPTH, D, IN_W)) * D ** -0.5,
        'gla_w_dec': nrm(ks[8], (DEPTH, 2, GLA_RANK, GLA_QK)) * GLA_RANK ** -0.5,
        'gla_b_dec': nrm(ks[9], (DEPTH, 2, GLA_QK)) * 0.1,
        'gla_norm_g': 1.0 + 0.02 * nrm(ks[10], (DEPTH, GLA_DV)),
        'q_norm_g': 1.0 + 0.02 * nrm(ks[11], (DEPTH, HEAD_DIM)),
        'k_norm_g': 1.0 + 0.02 * nrm(ks[12], (DEPTH, HEAD_DIM)),
        'sink_logit': nrm(ks[13], (DEPTH, SWA_HEADS)),
        'pool_w': nrm(ks[14], (DEPTH, len(POOL_WINDOWS), POOL_GROUP, POOL_GROUP)) * POOL_GROUP ** -0.5,
        'pool_scale': 1.0 + 0.1 * nrm(ks[15], (DEPTH, POOL_W)),
        'w_out': nrm(ks[16], (DEPTH, MIX_W, D)) * MIX_W ** -0.5,
        'norm2_g': 1.0 + 0.02 * nrm(ks[17], (DEPTH, D)),
        'w_up': nrm(ks[18], (DEPTH, D, 2 * D_FF)) * D ** -0.5,
        'conv_w': nrm(ks[19], (DEPTH, CONV_W, 2 * D_FF)) * CONV_W ** -0.5,
        'conv_b': nrm(ks[20], (DEPTH, 2 * D_FF)) * 0.02,
        'w_down': nrm(ks[21], (DEPTH, D_FF, D)) * D_FF ** -0.5,
    }


def reference(x, c, ctx, c_ctx, w_ada, b_ada, norm1_g, w_in, gla_w_dec, gla_b_dec, gla_norm_g,
              q_norm_g, k_norm_g, sink_logit, pool_w, pool_scale, w_out, norm2_g, w_up, conv_w,
              conv_b, w_down):
    cos, sin = rope_2d_tables(x.shape[1])
    c_act = jax.nn.silu(c)
    cc_act = jax.nn.silu(c_ctx)
    for l in range(DEPTH):
        mod = (c_act @ w_ada[l] + b_ada[l])[:, None, :]
        modc = cc_act @ w_ada[l] + b_ada[l]
        x, ctx = hybrid_layer(x, ctx, mod, modc, norm1_g[l], w_in[l], gla_w_dec[l], gla_b_dec[l],
                              gla_norm_g[l], q_norm_g[l], k_norm_g[l], sink_logit[l], pool_w[l],
                              pool_scale[l], w_out[l], norm2_g[l], w_up[l], conv_w[l], conv_b[l],
                              w_down[l], cos, sin, l < DEPTH - 1)
    return x
```

```cpp
#include <hip/hip_runtime.h>
#include <hip/hip_cooperative_groups.h>
#include <cstdio>
#include <cstdint>
namespace cg = cooperative_groups;
#define REP_GLAA 1
#define REP_GLAC 1
#define REP_SWA 1
#define REP_MIX 1
#define REP_GEMM 1
#define REP_NORM 1
#define REP_PRO 1
namespace pg8 {
#define PG8_LAS __attribute__((address_space(3)))
typedef unsigned short bf16_t;
typedef short bf16x8 __attribute__((ext_vector_type(8)));
typedef float f32x4 __attribute__((ext_vector_type(4)));
typedef unsigned u32x4 __attribute__((ext_vector_type(4)));
typedef unsigned u32x2 __attribute__((ext_vector_type(2)));
constexpr int BM = 256, BK = 64, HALF = 128, HTB = HALF * BK * 2  , STAGE_BYTES = 8 * HTB, NXCD = 8, WGM = 8;

__host__ __device__ __forceinline__ int lds_byte(int r, int c) { const int st = (r >> 4) * 2 + (c >> 5), rr = r & 15, cc = c & 31, ob = rr * 64 + cc * 2; return st * 1024 + (ob ^ (((ob >> 9) & 1) << 5)); }
__host__ __device__ __forceinline__ void stage_rc(int b, int& R, int& C) { const int st = b / 1024, sb = b % 1024, swz = sb ^ (((sb >> 9) & 1) << 5); R = (st >> 1) * 16 + swz / 64; C = (st & 1) * 32 + (swz % 64) / 2; }
__host__ __device__ __forceinline__ int perm32(int rho) { const int n = rho >> 4, i = rho & 15; return 8 * (i >> 2) + 4 * n + (i & 3); }

struct Unit { int pm, pn; };
struct Gemm { const bf16_t* A; const bf16_t* Bt; int M, N, K; int ld; };

struct StaticOrder {
    int nM, nN, nwg, G, c;
    __host__ __device__ void init(int M, int N, int G_, int c_) { nM = M / BM; nN = N / BM; nwg = nM * nN; G = G_; c = c_; }
    __host__ __device__ bool next(int i, Unit& u) const {
        const long L = (long)i * G + c; if (L >= nwg) return false;
        int wgid = (int)L; { const int q = nwg / NXCD, r = nwg % NXCD, xcd = wgid % NXCD, off = wgid / NXCD; wgid = (xcd < r ? xcd * (q + 1) : r * (q + 1) + (xcd - r) * q) + off; }
        const int nig = WGM * nN, gid = wgid / nig, fm = gid * WGM, gsz = (nM - fm) < WGM ? (nM - fm) : WGM;
        u.pm = fm + ((wgid % nig) % gsz); u.pn = (wgid % nig) / gsz; return true;
    }
    __device__ __forceinline__ void a_ready(const Unit&) const {}
    __device__ __forceinline__ void done(const Unit&) const {}
    __device__ __forceinline__ long arow(int pm) const { return (long)pm * BM; }
};
struct ConvOrder : StaticOrder {
    __device__ __forceinline__ long arow(int pm) const { if (pm < 132) { const int b = pm / 33, i = pm - b * 33; return (long)b * 8192 + 254 * i - 1; } return 32768 + (long)(pm - 132) * 256; }
};

struct OneUnit { int pm, pn;
    __device__ __forceinline__ bool next(int i, Unit& u) const { if (i > 0) return false; u.pm = pm; u.pn = pn; return true; }
    __device__ __forceinline__ void a_ready(const Unit&) const {}
    __device__ __forceinline__ void done(const Unit&) const {}
    __device__ __forceinline__ long arow(int p) const { return (long)p * BM; }
};
typedef float f32x2p_t __attribute__((ext_vector_type(2))); typedef __bf16 bf16x2p_t __attribute__((ext_vector_type(2)));
__device__ __forceinline__ unsigned cvt_pk_bf16(float lo, float hi) { f32x2p_t v = {lo, hi}; bf16x2p_t b = __builtin_convertvector(v, bf16x2p_t); return __builtin_bit_cast(unsigned, b); }
__device__ __forceinline__ void swap16(float& a, float& b) { asm volatile("v_nop\n\tv_nop\n\tv_permlane16_swap_b32 %0, %1" : "+v"(a), "+v"(b)); }
__device__ __forceinline__ void swap32(float& a, float& b) { asm volatile("v_nop\n\tv_nop\n\tv_permlane32_swap_b32 %0, %1" : "+v"(a), "+v"(b)); }
__device__ __forceinline__ float xor16_32_sum(float v) { float a = v, b = v; swap16(a, b); v = a + b; a = v; b = v; swap32(a, b); return a + b; }
__device__ __forceinline__ float xor16_32_max(float v) { float a = v, b = v; swap16(a, b); v = fmaxf(a, b); a = v; b = v; swap32(a, b); return fmaxf(a, b); }
struct EpiBf16S {
    static constexpr bool PERM = true, AFTER_DRAIN = false;
    bf16_t* O; int ldc;
    __device__ __forceinline__ void operator()(const f32x4 (&acc)[2][2][4][2], const Unit& u, int wr, int wc, int fr, int fq) const {
        const int row0 = u.pm * BM + wr * 64 + fr; const int col0 = u.pn * BM + wc * 32 + 8 * fq;
#pragma unroll
        for (int ai = 0; ai < 2; ++ai)
#pragma unroll
            for (int m = 0; m < 4; ++m) { bf16_t* rowp = O + (size_t)(row0 + ai * HALF + m * 16) * ldc + col0;
#pragma unroll
                for (int bj = 0; bj < 2; ++bj) { const f32x4 v0 = acc[ai][bj][m][0], v1 = acc[ai][bj][m][1];
                    u32x4 w; w.x = cvt_pk_bf16(v0[0], v0[1]); w.y = cvt_pk_bf16(v0[2], v0[3]); w.z = cvt_pk_bf16(v1[0], v1[1]); w.w = cvt_pk_bf16(v1[2], v1[3]);
                    *(u32x4*)(rowp + bj * HALF) = w; } }
    }
};
struct EpiRes {
    static constexpr bool PERM = false, AFTER_DRAIN = false;
    const float* src_lat; const float* src_ctx; float* dst_lat; float* dst_ctx; const float* gate;
    __device__ __forceinline__ void operator()(const f32x4 (&acc)[2][2][4][2], const Unit& u, int wr, int wc, int fr, int fq) const {
        const float* src; float* dst; int b;
        if (u.pm < 128) { src = src_lat + (size_t)u.pm * BM * 1024; dst = dst_lat + (size_t)u.pm * BM * 1024; b = u.pm >> 5; }
        else { src = src_ctx + (size_t)(u.pm - 128) * BM * 1024; dst = dst_ctx + (size_t)(u.pm - 128) * BM * 1024; b = 4; }
        const float* g = gate + b * 6144;
        const int col0 = u.pn * BM + wc * 32 + 4 * fq;
#pragma unroll
        for (int bj = 0; bj < 2; ++bj)
#pragma unroll
            for (int n = 0; n < 2; ++n) { const f32x4 gv = *(const f32x4*)(g + col0 + bj * HALF + n * 16);
#pragma unroll
                for (int ai = 0; ai < 2; ++ai)
#pragma unroll
                    for (int m = 0; m < 4; ++m) { const size_t off = (size_t)(ai * HALF + wr * 64 + m * 16 + fr) * 1024 + col0 + bj * HALF + n * 16;
                        const f32x4 s = *(const f32x4*)(src + off); *(f32x4*)(dst + off) = s + gv * acc[ai][bj][m][n]; } }
    }
};

struct EpiPart {
    static constexpr bool PERM = false, AFTER_DRAIN = false;
    float* part; const float* gate;
    __device__ __forceinline__ void operator()(const f32x4 (&acc)[2][2][4][2], const Unit& u, int wr, int wc, int fr, int fq) const {
        const int col0 = u.pn * BM + wc * 32 + 4 * fq;
#pragma unroll
        for (int bj = 0; bj < 2; ++bj)
#pragma unroll
            for (int n = 0; n < 2; ++n) { const int cc = col0 + bj * HALF + n * 16; const f32x4 gv = *(const f32x4*)(gate + cc);
#pragma unroll
                for (int ai = 0; ai < 2; ++ai)
#pragma unroll
                    for (int m = 0; m < 4; ++m) *(f32x4*)(part + (size_t)(u.pm * BM + ai * HALF + wr * 64 + m * 16 + fr) * 1024 + cc) = gv * acc[ai][bj][m][n]; }
    }
};
__device__ __forceinline__ float dpp_ror1(float v) { return __builtin_bit_cast(float, __builtin_amdgcn_update_dpp(0, __builtin_bit_cast(int, v), 0x121, 0xf, 0xf, false)); }
__device__ __forceinline__ float dpp_ror15(float v) { return __builtin_bit_cast(float, __builtin_amdgcn_update_dpp(0, __builtin_bit_cast(int, v), 0x12F, 0xf, 0xf, false)); }
struct EpiConv {
    static constexpr bool PERM = true, AFTER_DRAIN = false;
    bf16_t* ACT; const float* cw; const float* cb; PG8_LAS float* xb;
    __device__ __forceinline__ void operator()(const f32x4 (&acc)[2][2][4][2], const Unit& u, int wr, int wc, int fr, int fq) const {
        int seqrow, tstart, T, vlo, vhi;
        if (u.pm < 132) { const int b = u.pm / 33, i = u.pm - b * 33; seqrow = b * 8192; tstart = 254 * i - 1; T = 8192; vlo = 1; vhi = 255; }
        else { seqrow = 32768 + (u.pm - 132) * 256; tstart = 0; T = 256; vlo = 0; vhi = 256; }
        const bool edge = (tstart <= 0) || (tstart + 256 >= T);
        const int ch0 = 128 * u.pn + 32 * wc + 8 * fq;
        f32x4 w0[2], w1[2], w2[2], bb[2];
#pragma unroll
        for (int bj = 0; bj < 2; ++bj) { const int col = bj * 2816 + ch0;
            w0[bj] = *(const f32x4*)(cw + col); w1[bj] = *(const f32x4*)(cw + 5632 + col); w2[bj] = *(const f32x4*)(cw + 11264 + col); bb[bj] = *(const f32x4*)(cb + col); }
#pragma unroll
        for (int ai = 0; ai < 2; ++ai) { const int blk = ai * 2 + wr;
            if (fr == 0) {
#pragma unroll
                for (int bj = 0; bj < 2; ++bj)
#pragma unroll
                    for (int n = 0; n < 2; ++n) *(PG8_LAS f32x4*)(xb + ((((blk * 2 + 0) * 4 + wc) * 4 + fq) * 16 + (bj * 2 + n) * 4)) = acc[ai][bj][0][n]; }
            if (fr == 15) {
#pragma unroll
                for (int bj = 0; bj < 2; ++bj)
#pragma unroll
                    for (int n = 0; n < 2; ++n) *(PG8_LAS f32x4*)(xb + ((((blk * 2 + 1) * 4 + wc) * 4 + fq) * 16 + (bj * 2 + n) * 4)) = acc[ai][bj][3][n]; } }
        asm volatile("s_waitcnt lgkmcnt(0)" ::: "memory"); __builtin_amdgcn_s_barrier(); asm volatile("" ::: "memory");
        const f32x4 zero4 = {0.f, 0.f, 0.f, 0.f};
#pragma unroll
        for (int n = 0; n < 2; ++n) {
            if (n == 1) {
#pragma unroll
                for (int bj = 0; bj < 2; ++bj) { const int col = bj * 2816 + ch0 + 4;
                    w0[bj] = *(const f32x4*)(cw + col); w1[bj] = *(const f32x4*)(cw + 5632 + col); w2[bj] = *(const f32x4*)(cw + 11264 + col); bb[bj] = *(const f32x4*)(cb + col); } }
#pragma unroll
            for (int ai = 0; ai < 2; ++ai) { const int blk = ai * 2 + wr;
#pragma unroll
                for (int m = 0; m < 4; ++m) { const int r = 128 * ai + 64 * wr + 16 * m + fr, t = tstart + r;
                    const bool upok = t >= 1, dnok = (t + 1) < T, store_ok = (r >= vlo) && (r < vhi) && (t < T);
                    f32x4 res[2];
#pragma unroll
                    for (int bj = 0; bj < 2; ++bj) { const f32x4 cur = acc[ai][bj][m][n];
                        f32x4 su = cur, sd = cur;
                        if (m > 0) { if (fr == 15) su = acc[ai][bj][m > 0 ? m - 1 : 0][n]; }
                        if (m < 3) { if (fr == 0) sd = acc[ai][bj][m < 3 ? m + 1 : 3][n]; }
                        f32x4 up, dn;
                        up[0] = dpp_ror1(su[0]); up[1] = dpp_ror1(su[1]); up[2] = dpp_ror1(su[2]); up[3] = dpp_ror1(su[3]);
                        dn[0] = dpp_ror15(sd[0]); dn[1] = dpp_ror15(sd[1]); dn[2] = dpp_ror15(sd[2]); dn[3] = dpp_ror15(sd[3]);
                        if (m == 0) { f32x4 halo = zero4; if (blk > 0) halo = *(const PG8_LAS f32x4*)(xb + (((((blk - 1) * 2 + 1) * 4 + wc) * 4 + fq) * 16 + (bj * 2 + n) * 4)); if (fr == 0) up = halo; }
                        if (m == 3) { f32x4 halo = zero4; if (blk < 3) halo = *(const PG8_LAS f32x4*)(xb + (((((blk + 1) * 2 + 0) * 4 + wc) * 4 + fq) * 16 + (bj * 2 + n) * 4)); if (fr == 15) dn = halo; }
                        if (edge) { if (!upok) up = zero4; if (!dnok) dn = zero4; }
                        res[bj] = bb[bj] + w0[bj] * up + w1[bj] * cur + w2[bj] * dn; }
                    if (store_ok) {
                        float o[4];
#pragma unroll
                        for (int j = 0; j < 4; ++j) { const float gg = res[1][j]; o[j] = gg * __builtin_amdgcn_rcpf(1.f + __expf(-gg)) * res[0][j]; }
                        u32x2 w; w.x = cvt_pk_bf16(o[0], o[1]); w.y = cvt_pk_bf16(o[2], o[3]);
                        *(u32x2*)(ACT + (size_t)(seqrow + t) * 2816 + ch0 + 4 * n) = w; } } }
            asm volatile("" ::: "memory");
        }
    }
};

template <class Epi, class Sched, bool ALIGN_EPI = false, bool SP2 = false>
__device__ __forceinline__ void gemm_phase(PG8_LAS unsigned char* lds, const Gemm g, const Sched& S, const Epi& E) {
    int tid_ = threadIdx.x; asm volatile("" : "+v"(tid_));
    const int tid = tid_, wid = __builtin_amdgcn_readfirstlane(tid >> 6), lane = tid & 63, wr = wid >> 2, wc = wid & 3, fr = lane & 15, fq = lane >> 4;
    const int K = g.K, nt = K / BK, LD = g.ld ? g.ld : g.K;
    unsigned voffA[2], voffB[2];
#pragma unroll
    for (int i = 0; i < 2; ++i) { int R, C; stage_rc(tid * 16 + i * 8192, R, C); const int Rb = Epi::PERM ? ((R & ~31) + perm32(R & 31)) : R;
        voffA[i] = (unsigned)(R * LD + C) * 2u; voffB[i] = (unsigned)(Rb * LD + C) * 2u; }
    const size_t kstep = (size_t)(BK * 2);
    const size_t hstep = (size_t)HALF * LD * 2;
    const size_t tstep = 2 * hstep;
    const unsigned ldsw = (unsigned)wid * 1024u;
    const int aoff = lds_byte(wr * 64 + fr, fq * 8), boff = lds_byte(wc * 32 + fr, fq * 8);
#define PG8_SA(b, h) (((b) * 2 + (h)) * HTB)
#define PG8_SB(b, h) ((4 + (b) * 2 + (h)) * HTB)
#define PG8_STAGE(bufoff, gbase, voff) do { _Pragma("unroll") for (int _i = 0; _i < 2; ++_i) \
        __builtin_amdgcn_global_load_lds((const unsigned*)((const char*)(gbase) + (voff)[_i]), (PG8_LAS unsigned*)(lds + (bufoff) + ldsw + _i * 8192), 16, 0, 0); } while (0)
#define PG8_LDA(dst, b, h) do { _Pragma("unroll") for (int m = 0; m < 4; ++m) _Pragma("unroll") for (int k = 0; k < 2; ++k) dst[m][k] = *(const PG8_LAS bf16x8*)(lds + PG8_SA(b, h) + aoff + m * 2048 + k * 1024); } while (0)
#define PG8_LDB(dst, b, h) do { _Pragma("unroll") for (int n = 0; n < 2; ++n) _Pragma("unroll") for (int k = 0; k < 2; ++k) dst[n][k] = *(const PG8_LAS bf16x8*)(lds + PG8_SB(b, h) + boff + n * 2048 + k * 1024); } while (0)
#define PG8_MMA(ai, bj, At, Bt) do { __builtin_amdgcn_s_setprio(1); _Pragma("unroll") for (int m = 0; m < 4; ++m) _Pragma("unroll") for (int n = 0; n < 2; ++n) _Pragma("unroll") for (int k = 0; k < 2; ++k) \
        acc[ai][bj][m][n] = __builtin_amdgcn_mfma_f32_16x16x32_bf16(Bt[n][k], At[m][k], acc[ai][bj][m][n], 0, 0, 0); __builtin_amdgcn_s_setprio(0); } while (0)
#define PG8_WAIT_V(n) asm volatile("s_waitcnt vmcnt(" #n ")" ::: "memory")
#define PG8_WAIT_L(n) asm volatile("s_waitcnt lgkmcnt(" #n ")" ::: "memory")
#define PG8_BAR __builtin_amdgcn_s_barrier()
#define PG8_SCHED __builtin_amdgcn_sched_barrier(0)
    Unit cur, nxt; int ui = 0;
    if (!S.next(0, cur)) return;
    f32x4 acc[2][2][4][2];
#pragma unroll
    for (int a = 0; a < 2; ++a)
#pragma unroll
        for (int b = 0; b < 2; ++b)
#pragma unroll
            for (int m = 0; m < 4; ++m)
#pragma unroll
                for (int n = 0; n < 2; ++n) acc[a][b][m][n] = (f32x4){0.f, 0.f, 0.f, 0.f};
    bf16x8 At[4][2], B0[2][2], B1[2][2];
    const long rowb = (long)LD * 2;
    const char* cA = (const char*)g.A + S.arow(cur.pm) * rowb; const char* cB = (const char*)g.Bt + (size_t)cur.pn * tstep;
    S.a_ready(cur);
    if constexpr (SP2) {
        PG8_STAGE(PG8_SB(0, 0), cB, voffB); PG8_STAGE(PG8_SB(0, 1), cB + hstep, voffB); PG8_STAGE(PG8_SA(0, 0), cA, voffA); PG8_STAGE(PG8_SA(0, 1), cA + hstep, voffA);
        if (wr == 1) PG8_BAR;
        PG8_WAIT_V(2); PG8_BAR;
        PG8_STAGE(PG8_SB(1, 0), cB + kstep, voffB); PG8_STAGE(PG8_SA(1, 0), cA + kstep, voffA); PG8_STAGE(PG8_SB(1, 1), cB + hstep + kstep, voffB);
        PG8_WAIT_V(6); PG8_BAR;
    } else {
        PG8_STAGE(PG8_SB(0, 0), cB, voffB); PG8_STAGE(PG8_SA(0, 0), cA, voffA); PG8_STAGE(PG8_SB(0, 1), cB + hstep, voffB); PG8_STAGE(PG8_SA(0, 1), cA + hstep, voffA);
        if (wr == 1) PG8_BAR;
        PG8_WAIT_V(4); PG8_BAR;
        PG8_STAGE(PG8_SB(1, 0), cB + kstep, voffB); PG8_STAGE(PG8_SA(1, 0), cA + kstep, voffA); PG8_STAGE(PG8_SB(1, 1), cB + hstep + kstep, voffB);
        PG8_WAIT_V(6); PG8_BAR;
    }
    for (;;) {
        const bool has_next = S.next(ui + 1, nxt);
        const char* nA = has_next ? (const char*)g.A + S.arow(nxt.pm) * rowb : cA; const char* nB = has_next ? (const char*)g.Bt + (size_t)nxt.pn * tstep : cB;
        for (int t = 0; t < nt; t += 2) {
            const bool last = (t == nt - 2);
            const char* a1 = cA + (size_t)(t + 1) * kstep;
            const char* a2 = last ? nA : cA + (size_t)(t + 2) * kstep; const char* b2 = last ? nB : cB + (size_t)(t + 2) * kstep;
            const char* a3 = a2 + kstep; const char* b3 = b2 + kstep;
            if (last && has_next) S.a_ready(nxt);
            if constexpr (SP2) {
            PG8_LDB(B0, 0, 0); PG8_LDB(B1, 0, 1); PG8_SCHED; PG8_LDA(At, 0, 0); PG8_STAGE(PG8_SA(1, 1), a1 + hstep, voffA);
            PG8_WAIT_V(8); PG8_WAIT_L(0); PG8_BAR; PG8_MMA(0, 0, At, B0); PG8_MMA(0, 1, At, B1); PG8_BAR; PG8_SCHED;
            PG8_LDA(At, 0, 1); PG8_STAGE(PG8_SB(0, 0), b2, voffB); PG8_STAGE(PG8_SB(0, 1), b2 + hstep, voffB); PG8_STAGE(PG8_SA(0, 0), a2, voffA);
            PG8_WAIT_V(8); PG8_WAIT_L(0); PG8_BAR; PG8_MMA(1, 0, At, B0); PG8_MMA(1, 1, At, B1); PG8_BAR; PG8_SCHED;
            PG8_LDB(B0, 1, 0); PG8_LDB(B1, 1, 1); PG8_SCHED; PG8_LDA(At, 1, 0); PG8_STAGE(PG8_SA(0, 1), a2 + hstep, voffA);
            PG8_WAIT_V(8); PG8_WAIT_L(0); PG8_BAR; PG8_MMA(0, 0, At, B0); PG8_MMA(0, 1, At, B1); PG8_BAR; PG8_SCHED;
            PG8_LDA(At, 1, 1); PG8_STAGE(PG8_SB(1, 0), b3, voffB); PG8_STAGE(PG8_SB(1, 1), b3 + hstep, voffB); PG8_STAGE(PG8_SA(1, 0), a3, voffA);
            PG8_WAIT_V(8); PG8_WAIT_L(0); PG8_BAR; PG8_MMA(1, 0, At, B0); PG8_MMA(1, 1, At, B1); PG8_BAR; PG8_SCHED;
            } else {
            PG8_LDB(B0, 0, 0); PG8_SCHED; PG8_LDA(At, 0, 0); PG8_STAGE(PG8_SA(1, 1), a1 + hstep, voffA);
            PG8_WAIT_L(8); PG8_BAR; PG8_WAIT_L(0); PG8_MMA(0, 0, At, B0); PG8_BAR; PG8_SCHED;
            PG8_LDB(B1, 0, 1); PG8_STAGE(PG8_SB(0, 0), b2, voffB);
            PG8_BAR; PG8_WAIT_L(0); PG8_MMA(0, 1, At, B1); PG8_BAR;
            PG8_LDA(At, 0, 1); PG8_STAGE(PG8_SA(0, 0), a2, voffA);
            PG8_BAR; PG8_WAIT_L(0); PG8_MMA(1, 0, At, B0); PG8_BAR; PG8_SCHED;
            PG8_STAGE(PG8_SB(0, 1), b2 + hstep, voffB);
            PG8_WAIT_V(6); PG8_BAR; PG8_MMA(1, 1, At, B1); PG8_BAR;
            PG8_LDB(B0, 1, 0); PG8_SCHED; PG8_LDA(At, 1, 0); PG8_STAGE(PG8_SA(0, 1), a2 + hstep, voffA);
            PG8_WAIT_L(8); PG8_BAR; PG8_WAIT_L(0); PG8_MMA(0, 0, At, B0); PG8_BAR; PG8_SCHED;
            PG8_LDB(B1, 1, 1); PG8_STAGE(PG8_SB(1, 0), b3, voffB);
            PG8_BAR; PG8_WAIT_L(0); PG8_MMA(0, 1, At, B1); PG8_BAR;
            PG8_LDA(At, 1, 1); PG8_STAGE(PG8_SA(1, 0), a3, voffA);
            PG8_BAR; PG8_WAIT_L(0); PG8_MMA(1, 0, At, B0); PG8_BAR; PG8_SCHED;
            PG8_STAGE(PG8_SB(1, 1), b3 + hstep, voffB);
            PG8_WAIT_V(6); PG8_BAR; PG8_MMA(1, 1, At, B1); PG8_BAR;
            }
        }
        if constexpr (ALIGN_EPI) { if (wr == 0) PG8_BAR; }
        if constexpr (!Epi::AFTER_DRAIN) { E(acc, cur, wr, wc, fr, fq); S.done(cur); }
        if (!has_next) break;
#pragma unroll
        for (int a = 0; a < 2; ++a)
#pragma unroll
            for (int b = 0; b < 2; ++b)
#pragma unroll
                for (int m = 0; m < 4; ++m)
#pragma unroll
                    for (int n = 0; n < 2; ++n) acc[a][b][m][n] = (f32x4){0.f, 0.f, 0.f, 0.f};
        cur = nxt; cA = nA; cB = nB; ++ui;
        if constexpr (ALIGN_EPI) { if (wr == 1) PG8_BAR; }
    }
    PG8_WAIT_V(0);
    if constexpr (!ALIGN_EPI) { if (wr == 0) PG8_BAR; }
    PG8_BAR;
    if constexpr (Epi::AFTER_DRAIN) { E.fused(acc, cur, wr, wc, fr, fq, lds, wid, lane); S.done(cur); }
#undef PG8_SA
#undef PG8_SB
#undef PG8_STAGE
#undef PG8_LDA
#undef PG8_LDB
#undef PG8_MMA
#undef PG8_WAIT_V
#undef PG8_WAIT_L
#undef PG8_BAR
#undef PG8_SCHED
}
}
typedef unsigned short bf16;
typedef short bf16x8 __attribute__((ext_vector_type(8)));
typedef float f32x4 __attribute__((ext_vector_type(4)));
typedef float f32x2 __attribute__((ext_vector_type(2)));
typedef float f32x16 __attribute__((ext_vector_type(16)));
typedef unsigned v4u __attribute__((ext_vector_type(4)));
typedef unsigned v2u __attribute__((ext_vector_type(2)));

constexpr int D = 1024, NB = 4, SEQ = 8192, CTXL = 256, MLAT = 32768, MCTX = 1024, MALL = 33792;
constexpr int INW = 2080, INP = 2304, DFF = 2816, DFF2 = 5632;
constexpr int C_GQ = 0, C_GK = 192, C_GV = 384, C_GG = 768, C_ZF = 1152, C_ZB = 1168, C_AQ = 1184, C_AK = 1568, C_AV = 1696, C_PU = 1824;
constexpr float EPS = 1e-6f;
constexpr size_t MiB = (size_t)1 << 20;
constexpr size_t WS_PWT = 1 * MiB + 512 * 1024;
constexpr size_t WS_MOD = 1 * MiB, WS_WIN = 2 * MiB, WS_WOUT = 11 * MiB, WS_WUP = 15 * MiB, WS_WDN = 37 * MiB, WS_CTX = 48 * MiB, WS_H = 52 * MiB,
                 WS_P = 120 * MiB, WS_MIX = 270 * MiB, WS_ST = 336 * MiB, WS_DEC = 411 * MiB, WS_SI = 416 * MiB  , WS_U = 120 * MiB, WS_ACT = 300 * MiB, WS_PART = 484 * MiB, WS_END = 500 * MiB;
constexpr size_t U_CHUNK_ELEMS = (size_t)8192 * 5632;
constexpr int LDS_BYTES = 163840;
constexpr int XB_OFF = 139264, CTRL_OFF = 155648;
constexpr int NCH = 132;

struct KP { const float* in[22]; float* out; unsigned char* ws; };
constexpr int PTAB_OFF = CTRL_OFF + 1024;
struct KPD {
    unsigned char* lds;
    __device__ __forceinline__ unsigned long long ld(int i) const { const unsigned long long v = *(const volatile __attribute__((address_space(3))) unsigned long long*)(unsigned)(PTAB_OFF + 8 * i);
        const unsigned lo = __builtin_amdgcn_readfirstlane((unsigned)v), hi = __builtin_amdgcn_readfirstlane((unsigned)(v >> 32)); return ((unsigned long long)hi << 32) | lo; }
    __device__ __forceinline__ const float* in(int i) const { return (const float*)(const __attribute__((address_space(1))) float*)ld(i); }
    __device__ __forceinline__ float* out() const { return (float*)(__attribute__((address_space(1))) float*)ld(22); }
    __device__ __forceinline__ unsigned char* ws() const { return (unsigned char*)(__attribute__((address_space(1))) unsigned char*)ld(23); }
};
enum { I_X = 0, I_C, I_CTX, I_CCTX, I_WADA, I_BADA, I_N1G, I_WIN, I_GWDEC, I_GBDEC, I_GNG, I_QNG, I_KNG, I_SINK, I_POOLW, I_POOLS, I_WOUT, I_N2G, I_WUP, I_CONVW, I_CONVB, I_WDOWN };

typedef short v4i16_t __attribute__((ext_vector_type(4)));
typedef float f32x2c_t __attribute__((ext_vector_type(2))); typedef __bf16 bf16x2c_t __attribute__((ext_vector_type(2)));
__device__ __forceinline__ unsigned cvtpk_b(float lo, float hi) { f32x2c_t v = {lo, hi}; bf16x2c_t b = __builtin_convertvector(v, bf16x2c_t); return __builtin_bit_cast(unsigned, b); }
#define LASP __attribute__((address_space(3)))
__device__ __forceinline__ unsigned cvtpk(float lo, float hi) { unsigned r; asm("v_cvt_pk_bf16_f32 %0, %1, %2" : "=v"(r) : "v"(lo), "v"(hi)); return r; }
__device__ __forceinline__ bf16x8 tr8(const unsigned short* lo_p, int hi_off) { const LASP unsigned short* p = (const LASP unsigned short*)lo_p;
    const v4i16_t lo = __builtin_amdgcn_ds_read_tr16_b64_v4i16((LASP v4i16_t*)p), hi = __builtin_amdgcn_ds_read_tr16_b64_v4i16((LASP v4i16_t*)(p + hi_off));
    return (bf16x8){lo[0], lo[1], lo[2], lo[3], hi[0], hi[1], hi[2], hi[3]}; }
__device__ __forceinline__ float bf2f(unsigned h) { return __uint_as_float(h << 16); }
__device__ __forceinline__ unsigned f2bf(float f) { unsigned u = __float_as_uint(f); return (u + 0x7fffu + ((u >> 16) & 1u)) >> 16; }
__device__ __forceinline__ unsigned pk2(float lo, float hi) { return cvtpk(lo, hi); }
__device__ __forceinline__ float lo16(unsigned w) { return __uint_as_float(w << 16); }
__device__ __forceinline__ float hi16(unsigned w) { return __uint_as_float(w & 0xffff0000u); }
__device__ __forceinline__ float silu_f(float x) { return x * __builtin_amdgcn_rcpf(1.f + __expf(-x)); }
#define LDS_WAIT() asm volatile("s_waitcnt lgkmcnt(0)" ::: "memory")
__device__ __forceinline__ float wave_sum(float v) {
#pragma unroll
    for (int o = 1; o < 64; o <<= 1) v += __shfl_xor(v, o);
    return v;
}

template <bool UPMAP>
__device__ __forceinline__ void transpose_item(const float* W, int K, int N, bf16* WT, float* scr, int item, int lane) {
    const int nblk = N / 32, kb = item / nblk, nb = item % nblk, k0 = 64 * kb, n0 = 32 * nb;
    { f32x4 v[8];
#pragma unroll
      for (int i = 0; i < 8; ++i) v[i] = *(const f32x4*)(W + (size_t)(k0 + 8 * i + (lane >> 3)) * N + n0 + 4 * (lane & 7));
#pragma unroll
      for (int i = 0; i < 8; ++i) { float* d = scr + (8 * i + (lane >> 3)) * 33 + 4 * (lane & 7); d[0] = v[i][0]; d[1] = v[i][1]; d[2] = v[i][2]; d[3] = v[i][3]; } }
    LDS_WAIT();
    const int c = lane & 7;
#pragma unroll
    for (int j = 0; j < 4; ++j) { const int n = (lane >> 3) + 8 * j; const float* s = scr + (8 * c) * 33 + n;
        v4u o; o.x = pk2(s[0 * 33], s[1 * 33]); o.y = pk2(s[2 * 33], s[3 * 33]); o.z = pk2(s[4 * 33], s[5 * 33]); o.w = pk2(s[6 * 33], s[7 * 33]);
        const int nsrc = n0 + n; int nrow = nsrc;
        if (UPMAP) { const int bj = nsrc / 2816, chn = nsrc - bj * 2816; nrow = (chn >> 7) * 256 + bj * 128 + (chn & 127); }
        *(v4u*)(WT + (size_t)nrow * K + k0 + 8 * c) = o; }
    LDS_WAIT();
}

template <int PART>
__device__ __forceinline__ void prologue(const KPD& kp, unsigned char* lds, int tid, int lane, int wave) {
    unsigned char* ws = kp.ws();
    float* scr = (float*)(lds + wave * 16384);
    const int gw = blockIdx.x * 8 + wave, NGW = gridDim.x * 8;
    constexpr int I_IN = 16 * 65, I_OUT = 16 * 32, I_UP = 16 * 176, I_DN = 44 * 32, PER = I_IN + I_OUT + I_UP + I_DN;
    if constexpr (PART == 1) {
    for (int it = gw; it < 2 * PER; it += NGW) {
        const int l = it / PER; int r = it % PER;
        if (r < I_IN) { transpose_item<false>(kp.in(I_WIN) + (size_t)l * D * INW, D, INW, (bf16*)(ws + WS_WIN) + (size_t)l * INP * D, scr, r, lane); continue; } r -= I_IN;
        if (r < I_OUT) { transpose_item<false>(kp.in(I_WOUT) + (size_t)l * D * D, D, D, (bf16*)(ws + WS_WOUT) + (size_t)l * D * D, scr, r, lane); continue; } r -= I_OUT;
        if (r < I_UP) { transpose_item<true>(kp.in(I_WUP) + (size_t)l * D * DFF2, D, DFF2, (bf16*)(ws + WS_WUP) + (size_t)l * DFF2 * D, scr, r, lane); continue; } r -= I_UP;
        transpose_item<false>(kp.in(I_WDOWN) + (size_t)l * DFF * D, DFF, D, (bf16*)(ws + WS_WDN) + (size_t)l * D * DFF, scr, r, lane);
    }
    { const int gt = blockIdx.x * 512 + tid, NT = gridDim.x * 512; constexpr int PADV = (INP - INW) * D * 2 / 16;
      for (int i = gt; i < 2 * PADV; i += NT) { const int l = i / PADV, r = i % PADV; *((v4u*)((bf16*)(ws + WS_WIN) + (size_t)l * INP * D + (size_t)INW * D) + r) = (v4u){0u, 0u, 0u, 0u}; } }
    __syncthreads();
    return;
    }
    { const int gt = blockIdx.x * 512 + tid;
      if (gt < 32768) { const int k = gt & 63, nn = (gt >> 6) & 63, lg = gt >> 12; ((bf16*)(ws + WS_PWT))[gt] = (bf16)f2bf(kp.in(I_POOLW)[(size_t)(lg * 64 + k) * 64 + nn]); } }
    { const int gt = blockIdx.x * 512 + tid, NT = gridDim.x * 512;
      for (int i = gt; i < MCTX * D / 4; i += NT) ((f32x4*)(ws + WS_CTX))[i] = ((const f32x4*)kp.in(I_CTX))[i]; }
    __syncthreads();
    float* cs = (float*)lds; float* red = cs + 5 * 1024;
    for (int item = blockIdx.x; item < 192; item += gridDim.x) {
        const int l = item / 96, n0 = (item % 96) * 64;
        for (int i = tid; i < 5 * 1024; i += 512) { const float v = (i < 4096) ? kp.in(I_C)[i] : kp.in(I_CCTX)[i - 4096]; cs[i] = silu_f(v); }
        __syncthreads();
        float a0 = 0.f, a1 = 0.f, a2 = 0.f, a3 = 0.f, a4 = 0.f;
        const float* w = kp.in(I_WADA) + (size_t)l * D * 6144 + n0 + lane;
        for (int k = wave * 128; k < wave * 128 + 128; ++k) { const float wv = w[(size_t)k * 6144];
            a0 += cs[k] * wv; a1 += cs[1024 + k] * wv; a2 += cs[2048 + k] * wv; a3 += cs[3072 + k] * wv; a4 += cs[4096 + k] * wv; }
        red[(wave * 5 + 0) * 64 + lane] = a0; red[(wave * 5 + 1) * 64 + lane] = a1; red[(wave * 5 + 2) * 64 + lane] = a2; red[(wave * 5 + 3) * 64 + lane] = a3; red[(wave * 5 + 4) * 64 + lane] = a4;
        __syncthreads();
        if (tid < 320) { const int r = tid / 64, c = tid % 64; float s = 0.f;
#pragma unroll
            for (int w8 = 0; w8 < 8; ++w8) s += red[(w8 * 5 + r) * 64 + c];
            ((float*)(ws + WS_MOD))[(size_t)(l * 5 + r) * 6144 + n0 + c] = s + kp.in(I_BADA)[l * 6144 + n0 + c]; }
        __syncthreads();
    }
}

template <int NR>
__device__ __forceinline__ void norm_group(int m0, const float* src_lat, const float* src_ctx, bf16* H, const float* gain, const float* mod, int shoff, int scoff, int lane, const float* part, float* ctx_out) {
    const float* xr = (m0 < MLAT) ? src_lat + (size_t)m0 * D : src_ctx + (size_t)(m0 - MLAT) * D;
    const int b = (m0 < MLAT) ? (m0 >> 13) : 4;
    f32x4 v[NR][4]; float rstd[NR];
#pragma unroll
    for (int i = 0; i < NR; ++i)
#pragma unroll
        for (int j = 0; j < 4; ++j) v[i][j] = *((const f32x4*)(xr + (size_t)i * D) + lane + 64 * j);
    if (part && m0 >= MLAT) {
#pragma unroll
        for (int i = 0; i < NR; ++i)
#pragma unroll
            for (int j = 0; j < 4; ++j) { const size_t o = (size_t)(m0 - MLAT + i) * D + 4 * (lane + 64 * j);
                const f32x4 p0 = *(const f32x4*)(part + o), p1 = *(const f32x4*)(part + (size_t)MCTX * D + o), p2 = *(const f32x4*)(part + (size_t)2 * MCTX * D + o), p3 = *(const f32x4*)(part + (size_t)3 * MCTX * D + o);
                v[i][j] = v[i][j] + ((p0 + p1) + (p2 + p3)); *(f32x4*)(ctx_out + o) = v[i][j]; }
    }
#pragma unroll
    for (int i = 0; i < NR; ++i) { float s = 0.f;
#pragma unroll
        for (int j = 0; j < 4; ++j) s += (v[i][j].x * v[i][j].x + v[i][j].y * v[i][j].y) + (v[i][j].z * v[i][j].z + v[i][j].w * v[i][j].w);
        rstd[i] = 1.0f / sqrtf(wave_sum(s) * (1.f / D) + EPS); }
    const float* mr = mod + b * 6144;
#pragma unroll
    for (int j = 0; j < 4; ++j) { const int idx = 4 * (lane + 64 * j);
        const f32x4 g = *(const f32x4*)(gain + idx), sc = *(const f32x4*)(mr + scoff + idx), sh = *(const f32x4*)(mr + shoff + idx);
        const f32x4 gs = g * (1.f + sc);
#pragma unroll
        for (int i = 0; i < NR; ++i) { const f32x4 y = v[i][j] * rstd[i] * gs + sh;
            v2u o; o.x = pk2(y.x, y.y); o.y = pk2(y.z, y.w);
            *(v2u*)(H + (size_t)(m0 + i) * D + idx) = o; } }
}
__device__ __forceinline__ void norm_pass(const float* src_lat, const float* src_ctx, bf16* H, const float* gain, const float* mod, int shoff, int scoff, int nrows, int lane, int wave, const float* part = nullptr, float* ctx_out = nullptr) {
    const int gw = blockIdx.x * 8 + wave, NGW = gridDim.x * 8;
    for (int q = gw; q < MLAT / 4; q += NGW) norm_group<4>(4 * q, src_lat, src_ctx, H, gain, mod, shoff, scoff, lane, part, ctx_out);
    for (int m = MLAT + gw; m < nrows; m += NGW) norm_group<1>(m, src_lat, src_ctx, H, gain, mod, shoff, scoff, lane, part, ctx_out);
}

template <int CTRL> __device__ __forceinline__ float dppf(float x) { return __builtin_bit_cast(float, __builtin_amdgcn_update_dpp(0, __builtin_bit_cast(int, x), CTRL, 0xf, 0xf, false)); }
__device__ __forceinline__ float row16_max(float v) { v = fmaxf(v, dppf<0xB1>(v)); v = fmaxf(v, dppf<0x4E>(v)); v = fmaxf(v, dppf<0x141>(v)); v = fmaxf(v, dppf<0x128>(v)); return v; }
__device__ __forceinline__ float row16_sum(float v) { v += dppf<0xB1>(v); v += dppf<0x4E>(v); v += dppf<0x141>(v); v += dppf<0x128>(v); return v; }
__device__ __forceinline__ void chunk_coords(int sc, int& b, int& n, int& rowbase) {
    if (sc < 512) { b = sc >> 7; n = sc & 127; rowbase = b * SEQ + n * 64; }
    else { const int j = sc - 512; b = j >> 2; n = 128 + (j & 3); rowbase = MLAT + b * CTXL + (j & 3) * 64; }
}
__device__ __forceinline__ float wave_incl_scan(float v) {
    v += __builtin_bit_cast(float, __builtin_amdgcn_update_dpp(0, __builtin_bit_cast(int, v), 0x111, 0xf, 0xf, true));
    v += __builtin_bit_cast(float, __builtin_amdgcn_update_dpp(0, __builtin_bit_cast(int, v), 0x112, 0xf, 0xf, true));
    v += __builtin_bit_cast(float, __builtin_amdgcn_update_dpp(0, __builtin_bit_cast(int, v), 0x114, 0xf, 0xf, true));
    v += __builtin_bit_cast(float, __builtin_amdgcn_update_dpp(0, __builtin_bit_cast(int, v), 0x118, 0xf, 0xf, true));
    v += __builtin_bit_cast(float, __builtin_amdgcn_update_dpp(0, __builtin_bit_cast(int, v), 0x142, 0xa, 0xf, false));
    v += __builtin_bit_cast(float, __builtin_amdgcn_update_dpp(0, __builtin_bit_cast(int, v), 0x143, 0xc, 0xf, false));
    return v;
}
__device__ __forceinline__ void gla_prefetch(v4u& pz0, v4u& pz1, v4u& pw0, v4u& pw1, const KPD& kp, int l, int pair, int lane, int wave) {
    const int half = wave >> 2, w4 = wave & 3, item = 2 * pair + half, h = item & 3, sc = item >> 2; int b, n, rowbase; chunk_coords(sc, b, n, rowbase);
    const int dir = w4 >> 1, d0 = 24 * (w4 & 1);
    const bf16* prow = (const bf16*)(kp.ws() + WS_P) + (size_t)(rowbase + lane) * INP;
    pz0 = *(const v4u*)(prow + (dir ? C_ZB : C_ZF)); pz1 = *(const v4u*)(prow + (dir ? C_ZB : C_ZF) + 8);
    const float* W = kp.in(I_GWDEC) + (size_t)((l * 2 + dir) * 16) * 192 + h * 48 + d0;
    const float* bias = kp.in(I_GBDEC) + (l * 2 + dir) * 192 + h * 48 + d0;
    unsigned w[6];
#pragma unroll
    for (int i = 0; i < 6; ++i) { const int e = lane + 64 * i; w[i] = __float_as_uint(W[(e / 24) * 192 + (e % 24)]); }
    pw0 = (v4u){w[0], w[1], w[2], w[3]}; pw1 = (v4u){w[4], w[5], __float_as_uint(bias[lane < 24 ? lane : 0]), 0u};
}
template <bool PHC>
__device__ __forceinline__ void gla_pair(const KPD& kp, int l, int pair, unsigned char* lds, int tid, int lane, int wave, v4u& pz0, v4u& pz1, v4u& pw0, v4u& pw1, int next_pair) {
    const int half = wave >> 2, w4 = wave & 3, t4 = tid & 255;
    const int item = 2 * pair + half;
    const int h = item & 3, sc = item >> 2; int b, n, rowbase; chunk_coords(sc, b, n, rowbase);
    unsigned char* L = lds + half * 69632;
    const bf16* P = (const bf16*)(kp.ws() + WS_P);
    float* ST = (float*)(kp.ws() + WS_ST); float* DEC = (float*)(kp.ws() + WS_DEC);
    const int dir = w4 >> 1, d0 = 24 * (w4 & 1);
    const bf16* prow = P + (size_t)(rowbase + lane) * INP;
    v4u vpre[3];
#pragma unroll
    for (int i = 0; i < 3; ++i) { const int idx = t4 + 256 * i; vpre[i] = *(const v4u*)(P + (size_t)(rowbase + idx / 12) * INP + C_GV + h * 96 + 8 * (idx % 12)); }
    v2u spre[9];
    if constexpr (PHC) { const bf16* SI = (const bf16*)(kp.ws() + WS_SI);
#pragma unroll
        for (int i = 0; i < 9; ++i) { const int idx = t4 + 256 * i; const int dd = idx / 1152, e = (idx % 1152) * 4;
            spre[i] = *(const v2u*)(SI + ((size_t)((dd * 4 + b) * NCH + n) * 4 + h) * 4608 + e); }
    }
    float z[16];
    { const v4u z0 = pz0, z1 = pz1;
      z[0] = lo16(z0.x); z[1] = hi16(z0.x); z[2] = lo16(z0.y); z[3] = hi16(z0.y); z[4] = lo16(z0.z); z[5] = hi16(z0.z); z[6] = lo16(z0.w); z[7] = hi16(z0.w);
      z[8] = lo16(z1.x); z[9] = hi16(z1.x); z[10] = lo16(z1.y); z[11] = hi16(z1.y); z[12] = lo16(z1.z); z[13] = hi16(z1.z); z[14] = lo16(z1.w); z[15] = hi16(z1.w); }
    v4u qraw[3], kraw[3];
#pragma unroll
    for (int i = 0; i < 3; ++i) { qraw[i] = *((const v4u*)(prow + C_GQ + h * 48 + d0) + i); kraw[i] = *((const v4u*)(prow + C_GK + h * 48 + d0) + i); }
    const int wvv[6] = {(int)pw0.x, (int)pw0.y, (int)pw0.z, (int)pw0.w, (int)pw1.x, (int)pw1.y};
    const int bvv = (int)pw1.z;
    float bc[24], tot[24];
#pragma unroll
    for (int c = 0; c < 24; ++c) {
        float pre = __int_as_float(__builtin_amdgcn_readlane(bvv, c));
#pragma unroll
        for (int r = 0; r < 16; ++r) pre += z[r] * __int_as_float(__builtin_amdgcn_readlane(wvv[(24 * r + c) >> 6], (24 * r + c) & 63));
        const float la = (fminf(pre, 0.f) - __logf(1.f + __expf(-fabsf(pre)))) * (1.f / 16.f);
        const float inc = wave_incl_scan(la);
        const float total = __int_as_float(__builtin_amdgcn_readlane(__float_as_int(inc), 63));
        bc[c] = dir ? (total - inc + la) : inc; tot[c] = total;
    }
    float qv[24], kv[24];
#pragma unroll
    for (int i = 0; i < 3; ++i) {
        qv[8 * i] = lo16(qraw[i].x); qv[8 * i + 1] = hi16(qraw[i].x); qv[8 * i + 2] = lo16(qraw[i].y); qv[8 * i + 3] = hi16(qraw[i].y);
        qv[8 * i + 4] = lo16(qraw[i].z); qv[8 * i + 5] = hi16(qraw[i].z); qv[8 * i + 6] = lo16(qraw[i].w); qv[8 * i + 7] = hi16(qraw[i].w);
        kv[8 * i] = lo16(kraw[i].x); kv[8 * i + 1] = hi16(kraw[i].x); kv[8 * i + 2] = lo16(kraw[i].y); kv[8 * i + 3] = hi16(kraw[i].y);
        kv[8 * i + 4] = lo16(kraw[i].z); kv[8 * i + 5] = hi16(kraw[i].z); kv[8 * i + 6] = lo16(kraw[i].w); kv[8 * i + 7] = hi16(kraw[i].w); }
    const size_t stbase = (size_t)((dir * 4 + b) * NCH + n);
    if constexpr (!PHC) {
        bf16* Vr = (bf16*)L;
        bf16* KE = (bf16*)(L + 13312);
        { unsigned kw[12];
#pragma unroll
          for (int i = 0; i < 12; ++i) kw[i] = pk2(kv[2 * i] * __expf(tot[2 * i] - bc[2 * i]), kv[2 * i + 1] * __expf(tot[2 * i + 1] - bc[2 * i + 1]));
          v4u* ko = (v4u*)(KE + (dir * 64 + lane) * 56 + d0);
#pragma unroll
          for (int i = 0; i < 3; ++i) ko[i] = (v4u){kw[4 * i], kw[4 * i + 1], kw[4 * i + 2], kw[4 * i + 3]}; }
        if (lane == 0) {
#pragma unroll
            for (int c = 0; c < 24; ++c) DEC[stbase * 192 + h * 48 + d0 + c] = __expf(tot[c]);
        }
#pragma unroll
        for (int i = 0; i < 3; ++i) { const int idx = t4 + 256 * i; const int t = idx / 12, ch = idx % 12; *(v4u*)(Vr + t * 104 + 8 * ch) = vpre[i]; }
        __syncthreads();
        if (next_pair >= 0) gla_prefetch(pz0, pz1, pw0, pw1, kp, l, next_pair, lane, wave);
        const int fr = lane & 15, fq = lane >> 4, q4 = fr >> 2, p4 = lane & 3;
#pragma unroll 1
        for (int ti = (w4 & 1); ti < 18; ti += 2) { const int vt = ti / 3, dt = ti % 3;
            f32x4 acc = {0.f, 0.f, 0.f, 0.f};
#pragma unroll
            for (int ks = 0; ks < 2; ++ks) {
                const bf16x8 a = tr8(Vr + (32 * ks + 8 * fq + q4) * 104 + 16 * vt + 4 * p4, 4 * 104);
                const bf16x8 bb = tr8(KE + (dir * 64 + 32 * ks + 8 * fq + q4) * 56 + 16 * dt + 4 * p4, 4 * 56);
                acc = __builtin_amdgcn_mfma_f32_16x16x32_bf16(a, bb, acc, 0, 0, 0); }
            *(v2u*)((bf16*)ST + (stbase * 4 + h) * 4608 + (size_t)(16 * dt + fr) * 96 + 16 * vt + 4 * fq) = (v2u){cvtpk_b(acc[0], acc[1]), cvtpk_b(acc[2], acc[3])}; }
    } else {
        bf16* AC = (bf16*)L;
        bf16* Vr = (bf16*)(L + 21504);
        bf16* SB = (bf16*)(L + 34816);
        bf16* KI = (bf16*)(L + 54784);
        const float qs = 0.14433756729740643f;
        { unsigned qw[12], kw[12];
#pragma unroll
          for (int i = 0; i < 12; ++i) { qw[i] = pk2(qv[2 * i] * qs * __expf(bc[2 * i]), qv[2 * i + 1] * qs * __expf(bc[2 * i + 1])); kw[i] = pk2(kv[2 * i] * __expf(-bc[2 * i]), kv[2 * i + 1] * __expf(-bc[2 * i + 1])); }
          v4u* qo = (v4u*)(AC + lane * 168 + 64 + dir * 48 + d0); v4u* ko = (v4u*)(KI + (dir * 64 + lane) * 56 + d0);
#pragma unroll
          for (int i = 0; i < 3; ++i) { qo[i] = (v4u){qw[4 * i], qw[4 * i + 1], qw[4 * i + 2], qw[4 * i + 3]}; ko[i] = (v4u){kw[4 * i], kw[4 * i + 1], kw[4 * i + 2], kw[4 * i + 3]}; } }
#pragma unroll
        for (int i = 0; i < 3; ++i) { const int idx = t4 + 256 * i; const int t = idx / 12, ch = idx % 12; *(v4u*)(Vr + t * 104 + 8 * ch) = vpre[i]; }
#pragma unroll
        for (int i = 0; i < 9; ++i) { const int idx = t4 + 256 * i; const int dd = idx / 1152, e = (idx % 1152) * 4, d = e / 96, v = e % 96;
            *(v2u*)(SB + (dd * 48 + d) * 104 + v) = spre[i]; }
        __syncthreads();
        { const int rt = w4 >> 1, ct = w4 & 1, r32 = lane & 31, hi = lane >> 5;
          f32x16 af, ab;
#pragma unroll
          for (int r = 0; r < 16; ++r) { af[r] = 0.f; ab[r] = 0.f; }
#pragma unroll
          for (int ks = 0; ks < 3; ++ks) {
              const bf16x8 a0 = *(const bf16x8*)(AC + (32 * rt + r32) * 168 + 64 + 16 * ks + 8 * hi);
              const bf16x8 b0 = *(const bf16x8*)(KI + (32 * ct + r32) * 56 + 16 * ks + 8 * hi);
              af = __builtin_amdgcn_mfma_f32_32x32x16_bf16(a0, b0, af, 0, 0, 0);
              const bf16x8 a1 = *(const bf16x8*)(AC + (32 * rt + r32) * 168 + 112 + 16 * ks + 8 * hi);
              const bf16x8 b1 = *(const bf16x8*)(KI + (64 + 32 * ct + r32) * 56 + 16 * ks + 8 * hi);
              ab = __builtin_amdgcn_mfma_f32_32x32x16_bf16(a1, b1, ab, 0, 0, 0); }
          const int j = 32 * ct + r32;
#pragma unroll
          for (int r = 0; r < 16; ++r) { const int i = 32 * rt + (r & 3) + 8 * (r >> 2) + 4 * hi;
              const float val = ((j <= i) ? af[r] : 0.f) + ((j >= i) ? ab[r] : 0.f);
              AC[i * 168 + j] = (bf16)(cvtpk(val, val) & 0xffffu); } }
        const int fr = lane & 15, fq = lane >> 4;
        unsigned short gpre[4][6];
#pragma unroll
        for (int r = 0; r < 4; ++r)
#pragma unroll
            for (int ct = 0; ct < 6; ++ct) gpre[r][ct] = P[(size_t)(rowbase + 16 * w4 + 4 * fq + r) * INP + C_GG + h * 96 + 16 * ct + fr];
        __syncthreads();
        if (next_pair >= 0) gla_prefetch(pz0, pz1, pw0, pw1, kp, l, next_pair, lane, wave);
        f32x4 o6[6];
#pragma unroll
        for (int ct = 0; ct < 6; ++ct) o6[ct] = (f32x4){0.f, 0.f, 0.f, 0.f};
        { const int q4 = fr >> 2, p4 = lane & 3;
#pragma unroll
          for (int ks = 0; ks < 2; ++ks) {
              const bf16x8 a = *(const bf16x8*)(AC + (16 * w4 + fr) * 168 + 32 * ks + 8 * fq);
#pragma unroll
              for (int ct = 0; ct < 6; ++ct) { const bf16x8 bb = tr8(Vr + (32 * ks + 8 * fq + q4) * 104 + 16 * ct + 4 * p4, 4 * 104);
                  o6[ct] = __builtin_amdgcn_mfma_f32_16x16x32_bf16(a, bb, o6[ct], 0, 0, 0); } }
#pragma unroll
          for (int ks = 2; ks < 5; ++ks) {
              const bf16x8 a = *(const bf16x8*)(AC + (16 * w4 + fr) * 168 + 32 * ks + 8 * fq);
#pragma unroll
              for (int ct = 0; ct < 6; ++ct) { const bf16x8 bb = tr8(SB + (32 * (ks - 2) + 8 * fq + q4) * 104 + 16 * ct + 4 * p4, 4 * 104);
                  o6[ct] = __builtin_amdgcn_mfma_f32_16x16x32_bf16(a, bb, o6[ct], 0, 0, 0); } } }
        bf16* MIX = (bf16*)(kp.ws() + WS_MIX);
        const float* gng = kp.in(I_GNG) + l * 96;
        float gn6[6];
#pragma unroll
        for (int ct = 0; ct < 6; ++ct) gn6[ct] = gng[16 * ct + fr];
#pragma unroll
        for (int r = 0; r < 4; ++r) { float ssq = 0.f;
#pragma unroll
            for (int ct = 0; ct < 6; ++ct) ssq += o6[ct][r] * o6[ct][r];
            ssq = row16_sum(ssq);
            const float rstd = 1.0f / sqrtf(ssq * (1.f / 96.f) + EPS);
            const int i = 16 * w4 + 4 * fq + r;
#pragma unroll
            for (int ct = 0; ct < 6; ++ct) MIX[(size_t)(rowbase + i) * D + h * 96 + 16 * ct + fr] = (bf16)f2bf(o6[ct][r] * rstd * gn6[ct] * silu_f(bf2f(gpre[r][ct]))); }
    }
}

__device__ __forceinline__ void prep_pool_item(const KPD& kp, int l, int sc, unsigned char* lds, int tid, int lane, int wave) {
    int b, n, rowbase; chunk_coords(sc, b, n, rowbase);
    const bool isctx = sc >= 512; const int s0 = isctx ? (n - 128) * 64 : n * 64; const int T = isctx ? CTXL : SEQ;
    bf16* P = (bf16*)(kp.ws() + WS_P);
    {
      const int sub = tid & 7, t = tid >> 3;
      const int fb = 8 * (sub & 1);
      const bool isx2 = (sub & 2) != 0;
      float cn[8], sn[8];
      if (!isctx) { const int sp = s0 + t; const float pos = (float)((sub >> 2) ? (sp & 63) : (sp >> 6));
#pragma unroll
          for (int i = 0; i < 8; ++i) { const float inv = exp2f(-(float)(fb + i) * (13.287712379549449f / 16.f));
              const float rev = pos * inv * 0.15915494309189535f; const float fr_ = rev - floorf(rev);
              sn[i] = __builtin_amdgcn_sinf(fr_); cn[i] = __builtin_amdgcn_cosf(fr_); if (!isx2) sn[i] = -sn[i]; } }
      else {
#pragma unroll
          for (int i = 0; i < 8; ++i) { cn[i] = 1.f; sn[i] = 0.f; } }
      bf16* prow_ = P + (size_t)(rowbase + t) * INP + 8 * sub;
      v4u vin[8];
#pragma unroll
      for (int hd = 0; hd < 8; ++hd) vin[hd] = *(const v4u*)(prow_ + (hd < 6 ? C_AQ + hd * 64 : C_AK + (hd - 6) * 64));
      const f32x4 gq0 = *(const f32x4*)(kp.in(I_QNG) + l * 64 + 8 * sub), gq1 = *(const f32x4*)(kp.in(I_QNG) + l * 64 + 8 * sub + 4);
      const f32x4 gk0 = *(const f32x4*)(kp.in(I_KNG) + l * 64 + 8 * sub), gk1 = *(const f32x4*)(kp.in(I_KNG) + l * 64 + 8 * sub + 4);
#pragma unroll
      for (int hd = 0; hd < 8; ++hd) {
          const f32x4 g0 = hd < 6 ? gq0 : gk0, g1 = hd < 6 ? gq1 : gk1;
          const float osc = hd < 6 ? 0.18033688011112042f : 1.0f;
          const v4u v = vin[hd];
          float x[8] = {lo16(v.x), hi16(v.x), lo16(v.y), hi16(v.y), lo16(v.z), hi16(v.z), lo16(v.w), hi16(v.w)};
          float ss = 0.f;
#pragma unroll
          for (int i = 0; i < 8; ++i) ss += x[i] * x[i];
          ss += __shfl_xor(ss, 1); ss += __shfl_xor(ss, 2); ss += __shfl_xor(ss, 4);
          const float rstd = 1.0f / sqrtf(ss * (1.f / 64.f) + EPS);
          x[0] *= rstd * g0.x; x[1] *= rstd * g0.y; x[2] *= rstd * g0.z; x[3] *= rstd * g0.w; x[4] *= rstd * g1.x; x[5] *= rstd * g1.y; x[6] *= rstd * g1.z; x[7] *= rstd * g1.w;
          if (!isctx) {
#pragma unroll
              for (int i = 0; i < 8; ++i) { const float other = __shfl_xor(x[i], 2); x[i] = x[i] * cn[i] + other * sn[i]; } }
          v4u o; o.x = pk2(x[0] * osc, x[1] * osc); o.y = pk2(x[2] * osc, x[3] * osc); o.z = pk2(x[4] * osc, x[5] * osc); o.w = pk2(x[6] * osc, x[7] * osc);
          *(v4u*)(prow_ + (hd < 6 ? C_AQ + hd * 64 : C_AK + (hd - 6) * 64)) = o; } }
    if (isctx && l != 0) return;
    bf16* AP = (bf16*)lds;
    const bf16* WT = (const bf16*)(kp.ws() + WS_PWT) + (size_t)l * 4 * 64 * 64;
    { const int t = tid >> 3, cgp = tid & 7, g = cgp >> 1, w2 = 1 << g  ; const int s = s0 + t;
      const int lo = max(s - w2, 0), hi = min(s + w2, T);
      const int cb = C_PU + g * 64 + (cgp & 1) * 32;
      float acc[32];
#pragma unroll
      for (int i = 0; i < 32; ++i) acc[i] = 0.f;
      for (int j = lo; j < hi; ++j) { const bf16* up = P + (size_t)(rowbase + j - s0) * INP + cb;
#pragma unroll
          for (int q = 0; q < 4; ++q) { const v4u v = *(const v4u*)(up + 8 * q);
              acc[8 * q] += lo16(v.x); acc[8 * q + 1] += hi16(v.x); acc[8 * q + 2] += lo16(v.y); acc[8 * q + 3] += hi16(v.y); acc[8 * q + 4] += lo16(v.z); acc[8 * q + 5] += hi16(v.z); acc[8 * q + 6] += lo16(v.w); acc[8 * q + 7] += hi16(v.w); } }
      const float rc = 1.0f / (float)(hi - lo);
      const bf16* up = P + (size_t)(rowbase + t) * INP + cb;
#pragma unroll
      for (int q = 0; q < 4; ++q) { const v4u v = *(const v4u*)(up + 8 * q);
          v4u o; o.x = pk2(acc[8 * q] * rc - lo16(v.x), acc[8 * q + 1] * rc - hi16(v.x)); o.y = pk2(acc[8 * q + 2] * rc - lo16(v.y), acc[8 * q + 3] * rc - hi16(v.y));
          o.z = pk2(acc[8 * q + 4] * rc - lo16(v.z), acc[8 * q + 5] * rc - hi16(v.z)); o.w = pk2(acc[8 * q + 6] * rc - lo16(v.w), acc[8 * q + 7] * rc - hi16(v.w));
          *(v4u*)(AP + (g * 64 + t) * 72 + (cgp & 1) * 32 + 8 * q) = o; } }
    __syncthreads();
    bf16* MIX = (bf16*)(kp.ws() + WS_MIX);
    const float* psc = kp.in(I_POOLS) + l * 256;
    const int r32 = lane & 31, hi = lane >> 5;
#pragma unroll
    for (int tt = 0; tt < 2; ++tt) { const int tile = wave * 2 + tt, g = tile >> 2, rt = (tile >> 1) & 1, ct = tile & 1;
        f32x16 acc;
#pragma unroll
        for (int r = 0; r < 16; ++r) acc[r] = 0.f;
#pragma unroll
        for (int ks = 0; ks < 4; ++ks) {
            const bf16x8 a = *(const bf16x8*)(AP + (g * 64 + 32 * rt + r32) * 72 + 16 * ks + 8 * hi);
            const bf16x8 bb = *(const bf16x8*)(WT + (g * 64 + 32 * ct + r32) * 64 + 16 * ks + 8 * hi);
            acc = __builtin_amdgcn_mfma_f32_32x32x16_bf16(a, bb, acc, 0, 0, 0); }
        const int nn = 32 * ct + r32; const float scl = psc[g * 64 + nn];
#pragma unroll
        for (int r = 0; r < 16; ++r) { const int i = 32 * rt + (r & 3) + 8 * (r >> 2) + 4 * hi;
            MIX[(size_t)(rowbase + i) * D + 768 + g * 64 + nn] = (bf16)f2bf(acc[r] * scl); } }
}
__device__ __forceinline__ void gla_scan(const KPD& kp, int tid) {
    if (tid >= 288) return;
    const int gid = blockIdx.x * 288 + tid;
    if (gid >= 2 * 4 * 9216) return;
    const int e2 = gid % 9216, db = gid / 9216, dir = db >> 2, elem = 2 * e2, h = elem / 4608, d = (elem % 4608) / 96;
    const bf16* ST = (const bf16*)(kp.ws() + WS_ST) + (size_t)db * NCH * 18432 + elem;
    bf16* SI = (bf16*)(kp.ws() + WS_SI) + (size_t)db * NCH * 18432 + elem;
    const float* DEC = (const float*)(kp.ws() + WS_DEC) + (size_t)db * NCH * 192 + h * 48 + d;
    f32x2 s = {0.f, 0.f};
#pragma unroll 1
    for (int s0 = 0; s0 < NCH; s0 += 22) {
        unsigned cs[22]; float dc[22];
#pragma unroll
        for (int u = 0; u < 22; ++u) { const int step = s0 + u; const int n = dir ? (131 - step) : (step < 4 ? 128 + step : step - 4);
            cs[u] = *(const unsigned*)(ST + (size_t)n * 18432); dc[u] = DEC[n * 192]; }
#pragma unroll
        for (int u = 0; u < 22; ++u) { const int step = s0 + u; const int n = dir ? (131 - step) : (step < 4 ? 128 + step : step - 4);
            *(unsigned*)(SI + (size_t)n * 18432) = pk2(s.x, s.y); s = dc[u] * s + (f32x2){lo16(cs[u]), hi16(cs[u])}; }
    }
}

__device__ __forceinline__ void swa_item(const KPD& kp, int l, int item, unsigned char* lds, int tid, int lane, int wave) {
    const bool isctx = item >= 512;
    int b, qblk, kvh, qrow0;
    if (!isctx) { kvh = item & 1; qblk = (item >> 1) & 63; b = item >> 7; qrow0 = b * SEQ + qblk * 128; }
    else { const int j = item - 512; kvh = j & 1; qblk = (j >> 1) & 1; b = j >> 2; qrow0 = MLAT + b * CTXL + qblk * 128; }
    const bf16* P = (const bf16*)(kp.ws() + WS_P);
    bf16* Kt = (bf16*)lds;
    bf16* Vs = (bf16*)(lds + 18432);
    const int fr = lane & 15, fq = lane >> 4;
    bf16x8 qf[3][2];
#pragma unroll
    for (int hh = 0; hh < 3; ++hh)
#pragma unroll
        for (int ks = 0; ks < 2; ++ks) qf[hh][ks] = *(const bf16x8*)(P + (size_t)(qrow0 + 16 * wave + fr) * INP + C_AQ + (kvh * 3 + hh) * 64 + 32 * ks + 8 * fq);
    float mrow[3], lrow[3]; f32x4 O[3][4];
#pragma unroll
    for (int hh = 0; hh < 3; ++hh) { mrow[hh] = kp.in(I_SINK)[l * 6 + kvh * 3 + hh] * 1.4426950408889634f; lrow[hh] = (fq == 0) ? 1.f : 0.f;
#pragma unroll
        for (int dt = 0; dt < 4; ++dt) O[hh][dt] = (f32x4){0.f, 0.f, 0.f, 0.f}; }
    int nt = 0; int krow[5]; int kmode[5];
#pragma unroll
    for (int kt = 0; kt < 5; ++kt) { krow[kt] = 0; kmode[kt] = 0; }
    int t0 = 0;
    if (!isctx) {
        if (qblk > 0) { krow[0] = b * SEQ + (qblk - 1) * 128; kmode[0] = 1; t0 = 1; }
    }
    const bool hasprev = !isctx && qblk > 0, hascur = !isctx, hasnext = !isctx && qblk < 63;
    const int s_prev = 0, s_next = hasprev ? 1 : 0, s_cur = s_next + (hasnext ? 1 : 0), s_c0 = s_cur + (hascur ? 1 : 0), s_c1 = s_c0 + 1;
    nt = s_c1 + 1;
    (void)t0; (void)s_prev;
    auto tile_row = [&](int i) -> int {
        if (hasprev && i == 0) return b * SEQ + (qblk - 1) * 128;
        if (hasnext && i == s_next) return b * SEQ + (qblk + 1) * 128;
        if (hascur && i == s_cur) return b * SEQ + qblk * 128;
        if (i == s_c0) return MLAT + b * CTXL;
        return MLAT + b * CTXL + 128; };
    auto tile_mode = [&](int i) -> int { if (hasprev && i == 0) return 1; if (hasnext && i == s_next) return 2; return 0; };
    v4u kpre[4], vpre2[4];
    const int nstage = (nt + 1) >> 1;
#define SWA_LOAD_STAGE(ST) do { _Pragma("unroll") for (int slot = 0; slot < 2; ++slot) if (2 * (ST) + slot < nt) { const int kr = tile_row(2 * (ST) + slot); \
        _Pragma("unroll") for (int i = 0; i < 2; ++i) { const int idx = tid + 512 * i, key = idx >> 3, c8 = idx & 7; const bf16* src = P + (size_t)(kr + key) * INP + kvh * 64 + 8 * c8; \
            kpre[2 * slot + i] = *(const v4u*)(src + C_AK); vpre2[2 * slot + i] = *(const v4u*)(src + C_AV); } } } while (0)
    SWA_LOAD_STAGE(0);
    const int q4 = (lane & 15) >> 2, p4 = lane & 3;
#pragma unroll 1
    for (int st = 0; st < nstage; ++st) {
        const int ta = 2 * st, ntl = (nt - ta) < 2 ? (nt - ta) : 2;
        __syncthreads();
#pragma unroll
        for (int slot = 0; slot < 2; ++slot) if (slot < ntl) {
#pragma unroll
            for (int i = 0; i < 2; ++i) { const int idx = tid + 512 * i, key = idx >> 3, c8 = idx & 7;
                *(v4u*)(Kt + slot * 18432 + key * 72 + 8 * c8) = kpre[2 * slot + i]; *(v4u*)(Vs + slot * 18432 + key * 72 + 8 * c8) = vpre2[2 * slot + i]; } }
        if (st + 1 < nstage) SWA_LOAD_STAGE(st + 1);
        __syncthreads();
#pragma unroll 1
        for (int h2 = 0; h2 < 2 * ntl; ++h2) {
            const int slot = h2 >> 1, half = h2 & 1, mode = tile_mode(ta + slot);
            const bf16* Ktt = Kt + slot * 18432; const bf16* Vss = Vs + slot * 18432;
            if ((mode == 1 && half == 0 && wave >= 4) || (mode == 2 && half == 1 && wave <= 3)) continue;
            f32x4 S[3][4];
#pragma unroll
            for (int ct = 0; ct < 4; ++ct) {
#pragma unroll
                for (int hh = 0; hh < 3; ++hh) S[hh][ct] = (f32x4){0.f, 0.f, 0.f, 0.f};
#pragma unroll
                for (int ks = 0; ks < 2; ++ks) { const bf16x8 kf = *(const bf16x8*)(Ktt + (64 * half + 16 * ct + fr) * 72 + 32 * ks + 8 * fq);
#pragma unroll
                    for (int hh = 0; hh < 3; ++hh) S[hh][ct] = __builtin_amdgcn_mfma_f32_16x16x32_bf16(kf, qf[hh][ks], S[hh][ct], 0, 0, 0); } }
            if (mode != 0) {
                const int qi = 16 * wave + fr;
#pragma unroll
                for (int ct = 0; ct < 4; ++ct)
#pragma unroll
                    for (int r = 0; r < 4; ++r) { const int key = 64 * half + 16 * ct + 4 * fq + r;
                        const bool bad = (mode == 1) ? (key < qi) : (key > qi);
                        if (bad) { S[0][ct][r] = -1e30f; S[1][ct][r] = -1e30f; S[2][ct][r] = -1e30f; } }
            }
            bf16x8 pf[3][2];
#pragma unroll
            for (int hh = 0; hh < 3; ++hh) {
                float mx = fmaxf(fmaxf(S[hh][0][0], S[hh][0][1]), fmaxf(S[hh][0][2], S[hh][0][3]));
#pragma unroll
                for (int ct = 1; ct < 4; ++ct) mx = fmaxf(mx, fmaxf(fmaxf(S[hh][ct][0], S[hh][ct][1]), fmaxf(S[hh][ct][2], S[hh][ct][3])));
                mx = pg8::xor16_32_max(mx);
                const float mnew = fmaxf(mrow[hh], mx), alpha = __builtin_amdgcn_exp2f(mrow[hh] - mnew);
                float rs = 0.f; unsigned pw[8];
#pragma unroll
                for (int ct = 0; ct < 4; ++ct) { const float p0 = __builtin_amdgcn_exp2f(S[hh][ct][0] - mnew), p1 = __builtin_amdgcn_exp2f(S[hh][ct][1] - mnew), p2 = __builtin_amdgcn_exp2f(S[hh][ct][2] - mnew), p3 = __builtin_amdgcn_exp2f(S[hh][ct][3] - mnew);
                    rs += (p0 + p1) + (p2 + p3); pw[2 * ct] = cvtpk_b(p0, p1); pw[2 * ct + 1] = cvtpk_b(p2, p3); }
                lrow[hh] = lrow[hh] * alpha + rs; mrow[hh] = mnew;
#pragma unroll
                for (int dt = 0; dt < 4; ++dt) O[hh][dt] *= alpha;
                pf[hh][0] = __builtin_bit_cast(bf16x8, (v4u){pw[0], pw[1], pw[2], pw[3]});
                pf[hh][1] = __builtin_bit_cast(bf16x8, (v4u){pw[4], pw[5], pw[6], pw[7]});
            }
#pragma unroll
            for (int c2 = 0; c2 < 2; ++c2)
#pragma unroll
                for (int dt = 0; dt < 4; ++dt) {
                    const __attribute__((address_space(3))) bf16* vp = (const __attribute__((address_space(3))) bf16*)Vss + (64 * half + 32 * c2 + 4 * fq + q4) * 72 + 16 * dt + 4 * p4;
                    const v4i16_t lo = __builtin_amdgcn_ds_read_tr16_b64_v4i16((__attribute__((address_space(3))) v4i16_t*)vp);
                    const v4i16_t hi = __builtin_amdgcn_ds_read_tr16_b64_v4i16((__attribute__((address_space(3))) v4i16_t*)(vp + 16 * 72));
                    const bf16x8 vf = (bf16x8){lo[0], lo[1], lo[2], lo[3], hi[0], hi[1], hi[2], hi[3]};
#pragma unroll
                    for (int hh = 0; hh < 3; ++hh) O[hh][dt] = __builtin_amdgcn_mfma_f32_16x16x32_bf16(vf, pf[hh][c2], O[hh][dt], 0, 0, 0); }
        }
    }
#undef SWA_LOAD_STAGE
    bf16* MIX = (bf16*)(kp.ws() + WS_MIX);
#pragma unroll
    for (int hh = 0; hh < 3; ++hh) { float lt = lrow[hh];
        lt = pg8::xor16_32_sum(lt);
        const float inv = 1.0f / lt;
        bf16* o = MIX + (size_t)(qrow0 + 16 * wave + fr) * D + 384 + (kvh * 3 + hh) * 64 + 4 * fq;
#pragma unroll
        for (int dt = 0; dt < 4; ++dt) *(v2u*)(o + 16 * dt) = (v2u){cvtpk(O[hh][dt][0] * inv, O[hh][dt][1] * inv), cvtpk(O[hh][dt][2] * inv, O[hh][dt][3] * inv)}; }
}

__device__ __forceinline__ void act_pass(const KPD& kp, int l, const bf16* U, bf16* ACT, int nrows, int T, int tid) {
    const float* cw = kp.in(I_CONVW) + (size_t)l * 3 * DFF2; const float* cb = kp.in(I_CONVB) + (size_t)l * DFF2;
    const int total = nrows * 352;
    for (int idx = blockIdx.x * 512 + tid; idx < total; idx += gridDim.x * 512) {
        const int row = idx / 352, c = (idx % 352) * 8, t = row % T;
        float a[8], g[8];
#pragma unroll
        for (int i = 0; i < 8; ++i) { a[i] = cb[c + i]; g[i] = cb[DFF + c + i]; }
#pragma unroll
        for (int j = 0; j < 3; ++j) { const int tt = t + j - 1; if (tt < 0 || tt >= T) continue;
            const bf16* ur = U + (size_t)(row + j - 1) * DFF2 + c;
            const v4u ua = *(const v4u*)ur, ug = *(const v4u*)(ur + DFF);
            const float* wa = cw + j * DFF2 + c; const float* wg = wa + DFF;
            const float xa[8] = {lo16(ua.x), hi16(ua.x), lo16(ua.y), hi16(ua.y), lo16(ua.z), hi16(ua.z), lo16(ua.w), hi16(ua.w)};
            const float xg[8] = {lo16(ug.x), hi16(ug.x), lo16(ug.y), hi16(ug.y), lo16(ug.z), hi16(ug.z), lo16(ug.w), hi16(ug.w)};
#pragma unroll
            for (int i = 0; i < 8; ++i) { a[i] += wa[i] * xa[i]; g[i] += wg[i] * xg[i]; } }
        v4u o; o.x = pk2(silu_f(g[0]) * a[0], silu_f(g[1]) * a[1]); o.y = pk2(silu_f(g[2]) * a[2], silu_f(g[3]) * a[3]);
        o.z = pk2(silu_f(g[4]) * a[4], silu_f(g[5]) * a[5]); o.w = pk2(silu_f(g[6]) * a[6], silu_f(g[7]) * a[7]);
        *(v4u*)(ACT + (size_t)row * DFF + c) = o;
    }
}

#define LAS __attribute__((address_space(3)))
#define XB_TMO      128
#define XB_XCNT(j)  (256  + 64 * (j))
#define XB_XSUB(j)  (1280 + 64 * (j))
#define XB_XGEN(j)  (2304 + 64 * (j))
#define XB_TOP      3328
#define XB_TOPGEN   3392
#define XCD_BAR_WORDS 3456
#define XB_SPIN_CAP (1u << 18)

__device__ __forceinline__ unsigned xb_ld(unsigned* p)              { return __hip_atomic_load(p, __ATOMIC_RELAXED, __HIP_MEMORY_SCOPE_AGENT); }
__device__ __forceinline__ unsigned xb_add(unsigned* p, unsigned v) { return __hip_atomic_fetch_add(p, v, __ATOMIC_RELAXED, __HIP_MEMORY_SCOPE_AGENT); }
__device__ __forceinline__ unsigned xb_xcc_id() { return (unsigned)__builtin_amdgcn_s_getreg((3 << 11) | 20) & 0xFu; }
#define XB_SPIN(cond, bar) do { unsigned _sp = 0; while (cond) { __builtin_amdgcn_s_sleep(1); \
    if ((++_sp & 255u) == 0u) { if (xb_ld(&(bar)[XB_TMO])) break; if (_sp > XB_SPIN_CAP) { atomicAdd(&(bar)[XB_TMO], 1u); break; } } } } while (0)

struct XcdBarrier {
    unsigned* bar; unsigned x;
    volatile LAS unsigned* st;
};

__device__ __forceinline__ XcdBarrier xcd_barrier_post(unsigned* bar, volatile LAS unsigned* st) {
    XcdBarrier b; b.bar = bar; b.x = xb_xcc_id(); b.st = st;
    if (threadIdx.x == 0) (void)xb_add(&bar[XB_XCNT(b.x)], 1u);
    return b;
}
__device__ __forceinline__ void xcd_barrier_complete(unsigned* bar, unsigned x, unsigned& nloc, unsigned& nx) {
    const unsigned G = gridDim.x * gridDim.y * gridDim.z;
    unsigned sum, cnt, mine, sp = 0u;
    for (;;) {
        sum = 0u; cnt = 0u; mine = 0u;
#pragma unroll
        for (unsigned j = 0; j < 16; ++j) { const unsigned c = xb_ld(&bar[XB_XCNT(j)]); sum += c; cnt += (c > 0u) ? 1u : 0u; mine = (j == x) ? c : mine; }
        if (sum == G) break;
        __builtin_amdgcn_s_sleep(1);
        if ((++sp & 255u) == 0u) { if (xb_ld(&bar[XB_TMO])) break; if (sp > XB_SPIN_CAP) { atomicAdd(&bar[XB_TMO], 1u); break; } }
    }
    nloc = mine > 0u ? mine : 1u; nx = cnt > 0u ? cnt : 1u;
}

__device__ __forceinline__ void xcd_barrier(const XcdBarrier& b) {
    asm volatile("s_waitcnt vmcnt(0)" ::: "memory");
    __syncthreads();
    if (threadIdx.x == 0) {
        unsigned* bar = b.bar;
        __builtin_amdgcn_s_waitcnt(0);
        unsigned nloc = b.st[0], nx = b.st[1];
        if (nloc == 0u) { xcd_barrier_complete(bar, b.x, nloc, nx); b.st[0] = nloc; b.st[1] = nx; }
        const unsigned old = xb_add(&bar[XB_XSUB(b.x)], 1u);
        const unsigned gen = old / nloc;
        if (old + 1u == (gen + 1u) * nloc) {
            __builtin_amdgcn_fence(__ATOMIC_RELEASE, "agent");
            asm volatile("s_waitcnt vmcnt(0)" ::: "memory");
            const unsigned og = xb_add(&bar[XB_TOP], 1u);
            const unsigned tg = og / nx;
            if (og + 1u == (tg + 1u) * nx) xb_add(&bar[XB_TOPGEN], 1u);
            else XB_SPIN(xb_ld(&bar[XB_TOPGEN]) == tg, bar);
            __builtin_amdgcn_fence(__ATOMIC_ACQUIRE, "agent");
            xb_add(&bar[XB_XGEN(b.x)], 1u);
            asm volatile("s_waitcnt vmcnt(0)" ::: "memory");
        } else {
            XB_SPIN(xb_ld(&bar[XB_XGEN(b.x)]) == gen, bar);
            __builtin_amdgcn_fence(__ATOMIC_ACQUIRE, "agent");
            asm volatile("s_waitcnt vmcnt(0)" ::: "memory");
        }
    }
    __syncthreads();
}

__global__ void __launch_bounds__(512, 2) fwd_kernel(KP kparg) {
    extern __shared__ __attribute__((aligned(16))) unsigned char lds[];
    int tid = threadIdx.x, lane = tid & 63, wave = __builtin_amdgcn_readfirstlane(tid >> 6);
#define XITEM(it) (((it) & ~255) + (c & 7) * 32 + (c >> 3))
#define FRESH() do { tid = threadIdx.x; asm volatile("" : "+v"(tid)); lane = tid & 63; wave = __builtin_amdgcn_readfirstlane(tid >> 6); } while (0)
    if (tid == 0) { unsigned long long* tb = (unsigned long long*)(lds + PTAB_OFF);
#pragma unroll
        for (int i = 0; i < 22; ++i) tb[i] = (unsigned long long)kparg.in[i];
        tb[22] = (unsigned long long)kparg.out; tb[23] = (unsigned long long)kparg.ws; }
    __syncthreads();
    if (tid < 64) ((unsigned*)(lds + CTRL_OFF))[tid] = 0u;
    __syncthreads();
    KPD kp{lds};
    unsigned char* ws = kp.ws();
    PG8_LAS unsigned char* ldsg = (PG8_LAS unsigned char*)lds;
    bf16* H = (bf16*)(ws + WS_H); bf16* Pm = (bf16*)(ws + WS_P); bf16* MIX = (bf16*)(ws + WS_MIX); bf16* ACT = (bf16*)(ws + WS_ACT);
    float* CTXB = (float*)(ws + WS_CTX);
    const int G = gridDim.x, c = blockIdx.x;

    (void)xcd_barrier_post((unsigned*)ws + 1024, (volatile LAS unsigned*)(lds + CTRL_OFF) + 8);
#define GRIDBAR() do { XcdBarrier b_; b_.bar = (unsigned*)kp.ws() + 1024; b_.x = xb_xcc_id(); b_.st = (volatile LAS unsigned*)(lds + CTRL_OFF) + 8; xcd_barrier(b_); } while (0)
#ifndef NO_PRO
    prologue<0>(kp, lds, tid, lane, wave); __syncthreads();
#endif
    GRIDBAR();
#pragma unroll 1
    for (int l = 0; l < 2; ++l) {
        const float* mod = (const float*)(ws + WS_MOD) + (size_t)l * 5 * 6144;
        const float* xin = l ? kp.out() : kp.in(I_X); const float* cin = l ? CTXB : kp.in(I_CTX);
        FRESH();
#ifndef NO_PRO
        if (l == 0) { prologue<1>(kp, lds, tid, lane, wave); }
#endif
        for (int rep = 0; rep < REP_NORM; ++rep)
        norm_pass(xin, cin, H, kp.in(I_N1G) + l * D, mod, 0, 1024, MALL, lane, wave, l ? (const float*)(ws + WS_PART) : nullptr, CTXB);
        GRIDBAR();
        { pg8::Gemm g{H, (const bf16*)(ws + WS_WIN) + (size_t)l * INP * D, MALL, INP, D}; pg8::StaticOrder S; S.init(MALL, INP, G, c);
          pg8::EpiBf16S E{Pm, INP};
#ifndef NO_G1
          for (int rep = 0; rep < REP_GEMM; ++rep)
          pg8::gemm_phase<pg8::EpiBf16S, pg8::StaticOrder, true, true>(ldsg, g, S, E);
#endif
        }
        GRIDBAR();
        FRESH();
        v4u gz0 = {0u, 0u, 0u, 0u}, gz1 = gz0, gw0 = gz0, gw1 = gz0; { const int i0 = (G == 256) ? XITEM(c) : c; if (i0 < 1056) gla_prefetch(gz0, gz1, gw0, gw1, kp, l, i0, lane, wave); }
        for (int it = c; it < 1056 + 528 + 255; it += G) { const int item = (G == 256) ? XITEM(it) : it; if (item >= 1056 + 528) break;
#ifndef NO_GLAA
            if (item < 1056) { const int nx = (G == 256) ? XITEM(it + G) : it + G; gla_pair<false>(kp, l, item, lds, tid, lane, wave, gz0, gz1, gw0, gw1, nx < 1056 ? nx : -1); __syncthreads(); }
#endif
#ifndef NO_PREP
            if (item >= 1056) prep_pool_item(kp, l, item - 1056, lds, tid, lane, wave);
#endif
            __syncthreads();
        }
        GRIDBAR();
        FRESH();
        gla_scan(kp, tid);
        {
#ifndef NO_SWA
          for (int rep = 0; rep < REP_SWA; ++rep)
          for (int it = c; it < 512; it += G) { const int item = (G == 256) ? XITEM(it) : it; swa_item(kp, l, item, lds, tid, lane, wave); __syncthreads(); }
#endif
        }
        GRIDBAR();
        FRESH();
        { const int ngl = l ? 1024 : 1056;
#ifndef NO_GLAC
          v4u gz0 = {0u, 0u, 0u, 0u}, gz1 = gz0, gw0 = gz0, gw1 = gz0; { const int i0 = (G == 256) ? XITEM(c) : c; if (i0 < ngl) gla_prefetch(gz0, gz1, gw0, gw1, kp, l, i0, lane, wave); }
          for (int it = c; it < ngl + 255; it += G) { const int item = (G == 256) ? XITEM(it) : it; if (item >= ngl) break;
              const int nx = (G == 256) ? XITEM(it + G) : it + G; gla_pair<true>(kp, l, item, lds, tid, lane, wave, gz0, gz1, gw0, gw1, nx < ngl ? nx : -1); __syncthreads(); }
#endif
          if (l == 0) { const int v = (G == 256) ? ((c & 7) * 32 + (c >> 3)) : c; const int j = (G == 256) ? v - 32 : (c < 16 ? c : -1);
              if (j >= 0 && j < 16) { swa_item(kp, l, 512 + j, lds, tid, lane, wave); __syncthreads(); } }
        }
        GRIDBAR();
        const int M2 = l ? MLAT : MALL;
        { pg8::Gemm g{MIX, (const bf16*)(ws + WS_WOUT) + (size_t)l * D * D, MLAT, D, D}; pg8::StaticOrder S; S.init(MLAT, D, G, c);
          pg8::EpiRes E{xin, cin, kp.out(), CTXB, mod + 2048};
#ifndef NO_G2
          pg8::gemm_phase<pg8::EpiRes, pg8::StaticOrder, true, true>(ldsg, g, S, E);
#endif
        }
        if (l == 0 && c < 64) { const int j = c >> 2, sl = c & 3;
            pg8::Gemm g{MIX + (size_t)MLAT * D + sl * 256, (const bf16*)(ws + WS_WOUT) + sl * 256, MCTX, D, 256, D}; pg8::OneUnit S{j >> 2, j & 3};
            pg8::EpiPart E{(float*)(ws + WS_PART) + (size_t)sl * MCTX * D, mod + 2048 + 4 * 6144};
            pg8::gemm_phase<pg8::EpiPart, pg8::OneUnit, true, true>(ldsg, g, S, E); }
        GRIDBAR();
        FRESH();
        for (int rep = 0; rep < REP_NORM; ++rep)
        norm_pass(kp.out(), CTXB, H, kp.in(I_N2G) + l * D, mod, 3072, 4096, M2, lane, wave, l ? nullptr : (const float*)(ws + WS_PART), CTXB);
        GRIDBAR();
        { const int nMt = l ? 132 : 136;
          pg8::Gemm g{H, (const bf16*)(ws + WS_WUP) + (size_t)l * DFF2 * D, nMt * 256, DFF2, D}; pg8::ConvOrder S; S.init(nMt * 256, DFF2, G, c);
          pg8::EpiConv E{ACT, kp.in(I_CONVW) + (size_t)l * 3 * DFF2, kp.in(I_CONVB) + (size_t)l * DFF2, (PG8_LAS float*)(ldsg + XB_OFF)};
#ifndef NO_G3
          for (int rep = 0; rep < REP_GEMM; ++rep)
          pg8::gemm_phase<pg8::EpiConv, pg8::ConvOrder, true, true>(ldsg, g, S, E);
#endif
        }
        GRIDBAR();
        { pg8::Gemm g{ACT, (const bf16*)(ws + WS_WDN) + (size_t)l * D * DFF, MLAT, D, DFF}; pg8::StaticOrder S; S.init(MLAT, D, G, c);
          pg8::EpiRes E{kp.out(), CTXB, kp.out(), CTXB, mod + 5120};
#ifndef NO_G4
          pg8::gemm_phase<pg8::EpiRes, pg8::StaticOrder, true, true>(ldsg, g, S, E);
#endif
        }
        if (l == 0 && c < 64) { const int j = c >> 2, sl = c & 3; const int k0 = (sl == 0 ? 0 : sl == 1 ? 12 : sl == 2 ? 24 : 34) * 64, kl = (sl < 2 ? 12 : 10) * 64;
            pg8::Gemm g{ACT + (size_t)MLAT * DFF + k0, (const bf16*)(ws + WS_WDN) + k0, MCTX, D, kl, DFF}; pg8::OneUnit S{j >> 2, j & 3};
            pg8::EpiPart E{(float*)(ws + WS_PART) + (size_t)sl * MCTX * D, mod + 5120 + 4 * 6144};
            pg8::gemm_phase<pg8::EpiPart, pg8::OneUnit, true, true>(ldsg, g, S, E); }
        GRIDBAR();
    }
}

extern "C" void kernel_launch(void* const* d_in, const int* in_sizes, int n_in, void* d_out, int out_size, void* d_ws, size_t ws_size, hipStream_t stream) {
    static int grid = 0;
    if (grid == 0) {
        if (n_in != 22 || ws_size < WS_END) { fprintf(stderr, "kernel_launch: unexpected n_in %d / ws %zu\n", n_in, ws_size); grid = -1; return; }
        int dev = 0, cus = 0, per_cu = 0;
        hipGetDevice(&dev); hipDeviceGetAttribute(&cus, hipDeviceAttributeMultiprocessorCount, dev);
        hipFuncSetAttribute((const void*)fwd_kernel, hipFuncAttributeMaxDynamicSharedMemorySize, LDS_BYTES);
        hipOccupancyMaxActiveBlocksPerMultiprocessor(&per_cu, (const void*)fwd_kernel, 512, LDS_BYTES);
        if (per_cu < 1) { fprintf(stderr, "kernel_launch: occupancy query says %d blocks per CU\n", per_cu); per_cu = 1; }
        grid = cus * 1;
    }
    if (grid < 0) return;
    (void)hipMemsetAsync(d_ws, 0, 65536, stream);
    KP kp{};
    for (int i = 0; i < 22; ++i) kp.in[i] = (const float*)d_in[i];
    kp.out = (float*)d_out; kp.ws = (unsigned char*)d_ws;
    void* args[] = {&kp};
    hipError_t e = hipLaunchCooperativeKernel((const void*)fwd_kernel, dim3(grid), dim3(512), args, LDS_BYTES, stream);
    if (e != hipSuccess) fprintf(stderr, "cooperative launch failed: %s (grid %d)\n", hipGetErrorString(e), grid);
}
```

```cpp
#include <hip/hip_runtime.h>
#include <hip/hip_cooperative_groups.h>
#include <cstdio>
#include <cstdint>
namespace cg = cooperative_groups;
#define REP_GLAA 1
#define REP_GLAC 1
#define REP_SWA 1
#define REP_MIX 1
#define REP_GEMM 1
#define REP_NORM 1
#define REP_PRO 1
namespace pg8 {
#define PG8_LAS __attribute__((address_space(3)))
typedef unsigned short bf16_t;
typedef short bf16x8 __attribute__((ext_vector_type(8)));
typedef float f32x4 __attribute__((ext_vector_type(4)));
typedef unsigned u32x4 __attribute__((ext_vector_type(4)));
typedef unsigned u32x2 __attribute__((ext_vector_type(2)));
constexpr int BM = 256, BK = 64, HALF = 128, HTB = HALF * BK * 2  , STAGE_BYTES = 8 * HTB, NXCD = 8, WGM = 8;

__host__ __device__ __forceinline__ int lds_byte(int r, int c) { const int st = (r >> 4) * 2 + (c >> 5), rr = r & 15, cc = c & 31, ob = rr * 64 + cc * 2; return st * 1024 + (ob ^ (((ob >> 9) & 1) << 5)); }
__host__ __device__ __forceinline__ void stage_rc(int b, int& R, int& C) { const int st = b / 1024, sb = b % 1024, swz = sb ^ (((sb >> 9) & 1) << 5); R = (st >> 1) * 16 + swz / 64; C = (st & 1) * 32 + (swz % 64) / 2; }
__host__ __device__ __forceinline__ int perm32(int rho) { const int n = rho >> 4, i = rho & 15; return 8 * (i >> 2) + 4 * n + (i & 3); }

struct Unit { int pm, pn; };
struct Gemm { const bf16_t* A; const bf16_t* Bt; int M, N, K; int ld; };

struct StaticOrder {
    int nM, nN, nwg, G, c;
    __host__ __device__ void init(int M, int N, int G_, int c_) { nM = M / BM; nN = N / BM; nwg = nM * nN; G = G_; c = c_; }
    __host__ __device__ bool next(int i, Unit& u) const {
        const long L = (long)i * G + c; if (L >= nwg) return false;
        int wgid = (int)L; { const int q = nwg / NXCD, r = nwg % NXCD, xcd = wgid % NXCD, off = wgid / NXCD; wgid = (xcd < r ? xcd * (q + 1) : r * (q + 1) + (xcd - r) * q) + off; }
        const int nig = WGM * nN, gid = wgid / nig, fm = gid * WGM, gsz = (nM - fm) < WGM ? (nM - fm) : WGM;
        u.pm = fm + ((wgid % nig) % gsz); u.pn = (wgid % nig) / gsz; return true;
    }
    __device__ __forceinline__ void a_ready(const Unit&) const {}
    __device__ __forceinline__ void done(const Unit&) const {}
    __device__ __forceinline__ long arow(int pm) const { return (long)pm * BM; }
};
struct ConvOrder : StaticOrder {
    __device__ __forceinline__ long arow(int pm) const { if (pm < 132) { const int b = pm / 33, i = pm - b * 33; return (long)b * 8192 + 254 * i - 1; } return 32768 + (long)(pm - 132) * 256; }
};

struct OneUnit { int pm, pn;
    __device__ __forceinline__ bool next(int i, Unit& u) const { if (i > 0) return false; u.pm = pm; u.pn = pn; return true; }
    __device__ __forceinline__ void a_ready(const Unit&) const {}
    __device__ __forceinline__ void done(const Unit&) const {}
    __device__ __forceinline__ long arow(int p) const { return (long)p * BM; }
};
typedef float f32x2p_t __attribute__((ext_vector_type(2))); typedef __bf16 bf16x2p_t __attribute__((ext_vector_type(2)));
__device__ __forceinline__ unsigned cvt_pk_bf16(float lo, float hi) { f32x2p_t v = {lo, hi}; bf16x2p_t b = __builtin_convertvector(v, bf16x2p_t); return __builtin_bit_cast(unsigned, b); }
__device__ __forceinline__ void swap16(float& a, float& b) { asm volatile("v_nop\n\tv_nop\n\tv_permlane16_swap_b32 %0, %1" : "+v"(a), "+v"(b)); }
__device__ __forceinline__ void swap32(float& a, float& b) { asm volatile("v_nop\n\tv_nop\n\tv_permlane32_swap_b32 %0, %1" : "+v"(a), "+v"(b)); }
__device__ __forceinline__ float xor16_32_sum(float v) { float a = v, b = v; swap16(a, b); v = a + b; a = v; b = v; swap32(a, b); return a + b; }
__device__ __forceinline__ float xor16_32_max(float v) { float a = v, b = v; swap16(a, b); v = fmaxf(a, b); a = v; b = v; swap32(a, b); return fmaxf(a, b); }
struct EpiBf16S {
    static constexpr bool PERM = true, AFTER_DRAIN = false;
    bf16_t* O; int ldc; int ncols;
    __device__ __forceinline__ void operator()(const f32x4 (&acc)[2][2][4][2], const Unit& u, int wr, int wc, int fr, int fq) const {
        const int row0 = u.pm * BM + wr * 64 + fr; const int col0 = u.pn * BM + wc * 32 + 8 * fq;
#pragma unroll
        for (int ai = 0; ai < 2; ++ai)
#pragma unroll
            for (int m = 0; m < 4; ++m) { bf16_t* rowp = O + (size_t)(row0 + ai * HALF + m * 16) * ldc + col0;
#pragma unroll
                for (int bj = 0; bj < 2; ++bj) { if (col0 + bj * HALF >= ncols) continue; const f32x4 v0 = acc[ai][bj][m][0], v1 = acc[ai][bj][m][1];
                    u32x4 w; w.x = cvt_pk_bf16(v0[0], v0[1]); w.y = cvt_pk_bf16(v0[2], v0[3]); w.z = cvt_pk_bf16(v1[0], v1[1]); w.w = cvt_pk_bf16(v1[2], v1[3]);
                    *(u32x4*)(rowp + bj * HALF) = w; } }
    }
};
struct EpiRes {
    static constexpr bool PERM = false, AFTER_DRAIN = false;
    const float* src_lat; const float* src_ctx; float* dst_lat; float* dst_ctx; const float* gate;
    __device__ __forceinline__ void operator()(const f32x4 (&acc)[2][2][4][2], const Unit& u, int wr, int wc, int fr, int fq) const {
        const float* src; float* dst; int b;
        if (u.pm < 128) { src = src_lat + (size_t)u.pm * BM * 1024; dst = dst_lat + (size_t)u.pm * BM * 1024; b = u.pm >> 5; }
        else { src = src_ctx + (size_t)(u.pm - 128) * BM * 1024; dst = dst_ctx + (size_t)(u.pm - 128) * BM * 1024; b = 4; }
        const float* g = gate + b * 6144;
        const int col0 = u.pn * BM + wc * 32 + 4 * fq;
#pragma unroll
        for (int bj = 0; bj < 2; ++bj)
#pragma unroll
            for (int n = 0; n < 2; ++n) { const f32x4 gv = *(const f32x4*)(g + col0 + bj * HALF + n * 16);
#pragma unroll
                for (int ai = 0; ai < 2; ++ai)
#pragma unroll
                    for (int m = 0; m < 4; ++m) { const size_t off = (size_t)(ai * HALF + wr * 64 + m * 16 + fr) * 1024 + col0 + bj * HALF + n * 16;
                        const f32x4 s = *(const f32x4*)(src + off); *(f32x4*)(dst + off) = s + gv * acc[ai][bj][m][n]; } }
    }
};

struct EpiPart {
    static constexpr bool PERM = false, AFTER_DRAIN = false;
    float* part; const float* gate;
    __device__ __forceinline__ void operator()(const f32x4 (&acc)[2][2][4][2], const Unit& u, int wr, int wc, int fr, int fq) const {
        const int col0 = u.pn * BM + wc * 32 + 4 * fq;
#pragma unroll
        for (int bj = 0; bj < 2; ++bj)
#pragma unroll
            for (int n = 0; n < 2; ++n) { const int cc = col0 + bj * HALF + n * 16; const f32x4 gv = *(const f32x4*)(gate + cc);
#pragma unroll
                for (int ai = 0; ai < 2; ++ai)
#pragma unroll
                    for (int m = 0; m < 4; ++m) *(f32x4*)(part + (size_t)(u.pm * BM + ai * HALF + wr * 64 + m * 16 + fr) * 1024 + cc) = gv * acc[ai][bj][m][n]; }
    }
};
__device__ __forceinline__ float dpp_ror1(float v) { return __builtin_bit_cast(float, __builtin_amdgcn_update_dpp(0, __builtin_bit_cast(int, v), 0x121, 0xf, 0xf, false)); }
__device__ __forceinline__ float dpp_ror15(float v) { return __builtin_bit_cast(float, __builtin_amdgcn_update_dpp(0, __builtin_bit_cast(int, v), 0x12F, 0xf, 0xf, false)); }
struct EpiConv {
    static constexpr bool PERM = true, AFTER_DRAIN = false;
    bf16_t* ACT; const float* cw; const float* cb; PG8_LAS float* xb;
    __device__ __forceinline__ void operator()(const f32x4 (&acc)[2][2][4][2], const Unit& u, int wr, int wc, int fr, int fq) const {
        int seqrow, tstart, T, vlo, vhi;
        if (u.pm < 132) { const int b = u.pm / 33, i = u.pm - b * 33; seqrow = b * 8192; tstart = 254 * i - 1; T = 8192; vlo = 1; vhi = 255; }
        else { seqrow = 32768 + (u.pm - 132) * 256; tstart = 0; T = 256; vlo = 0; vhi = 256; }
        const bool edge = (tstart <= 0) || (tstart + 256 >= T);
        const int ch0 = 128 * u.pn + 32 * wc + 8 * fq;
        f32x4 w0[2], w1[2], w2[2], bb[2];
#pragma unroll
        for (int bj = 0; bj < 2; ++bj) { const int col = bj * 2816 + ch0;
            w0[bj] = *(const f32x4*)(cw + col); w1[bj] = *(const f32x4*)(cw + 5632 + col); w2[bj] = *(const f32x4*)(cw + 11264 + col); bb[bj] = *(const f32x4*)(cb + col); }
#pragma unroll
        for (int ai = 0; ai < 2; ++ai) { const int blk = ai * 2 + wr;
            if (fr == 0) {
#pragma unroll
                for (int bj = 0; bj < 2; ++bj)
#pragma unroll
                    for (int n = 0; n < 2; ++n) *(PG8_LAS f32x4*)(xb + ((((blk * 2 + 0) * 4 + wc) * 4 + fq) * 16 + (bj * 2 + n) * 4)) = acc[ai][bj][0][n]; }
            if (fr == 15) {
#pragma unroll
                for (int bj = 0; bj < 2; ++bj)
#pragma unroll
                    for (int n = 0; n < 2; ++n) *(PG8_LAS f32x4*)(xb + ((((blk * 2 + 1) * 4 + wc) * 4 + fq) * 16 + (bj * 2 + n) * 4)) = acc[ai][bj][3][n]; } }
        asm volatile("s_waitcnt lgkmcnt(0)" ::: "memory"); __builtin_amdgcn_s_barrier(); asm volatile("" ::: "memory");
        const f32x4 zero4 = {0.f, 0.f, 0.f, 0.f};
#pragma unroll
        for (int n = 0; n < 2; ++n) {
            if (n == 1) {
#pragma unroll
                for (int bj = 0; bj < 2; ++bj) { const int col = bj * 2816 + ch0 + 4;
                    w0[bj] = *(const f32x4*)(cw + col); w1[bj] = *(const f32x4*)(cw + 5632 + col); w2[bj] = *(const f32x4*)(cw + 11264 + col); bb[bj] = *(const f32x4*)(cb + col); } }
#pragma unroll
            for (int ai = 0; ai < 2; ++ai) { const int blk = ai * 2 + wr;
#pragma unroll
                for (int m = 0; m < 4; ++m) { const int r = 128 * ai + 64 * wr + 16 * m + fr, t = tstart + r;
                    const bool upok = t >= 1, dnok = (t + 1) < T, store_ok = (r >= vlo) && (r < vhi) && (t < T);
                    f32x4 res[2];
#pragma unroll
                    for (int bj = 0; bj < 2; ++bj) { const f32x4 cur = acc[ai][bj][m][n];
                        f32x4 su = cur, sd = cur;
                        if (m > 0) { if (fr == 15) su = acc[ai][bj][m > 0 ? m - 1 : 0][n]; }
                        if (m < 3) { if (fr == 0) sd = acc[ai][bj][m < 3 ? m + 1 : 3][n]; }
                        f32x4 up, dn;
                        up[0] = dpp_ror1(su[0]); up[1] = dpp_ror1(su[1]); up[2] = dpp_ror1(su[2]); up[3] = dpp_ror1(su[3]);
                        dn[0] = dpp_ror15(sd[0]); dn[1] = dpp_ror15(sd[1]); dn[2] = dpp_ror15(sd[2]); dn[3] = dpp_ror15(sd[3]);
                        if (m == 0) { f32x4 halo = zero4; if (blk > 0) halo = *(const PG8_LAS f32x4*)(xb + (((((blk - 1) * 2 + 1) * 4 + wc) * 4 + fq) * 16 + (bj * 2 + n) * 4)); if (fr == 0) up = halo; }
                        if (m == 3) { f32x4 halo = zero4; if (blk < 3) halo = *(const PG8_LAS f32x4*)(xb + (((((blk + 1) * 2 + 0) * 4 + wc) * 4 + fq) * 16 + (bj * 2 + n) * 4)); if (fr == 15) dn = halo; }
                        if (edge) { if (!upok) up = zero4; if (!dnok) dn = zero4; }
                        res[bj] = bb[bj] + w0[bj] * up + w1[bj] * cur + w2[bj] * dn; }
                    if (store_ok) {
                        float o[4];
#pragma unroll
                        for (int j = 0; j < 4; ++j) { const float gg = res[1][j]; o[j] = gg * __builtin_amdgcn_rcpf(1.f + __expf(-gg)) * res[0][j]; }
                        u32x2 w; w.x = cvt_pk_bf16(o[0], o[1]); w.y = cvt_pk_bf16(o[2], o[3]);
                        *(u32x2*)(ACT + (size_t)(seqrow + t) * 2816 + ch0 + 4 * n) = w; } } }
            asm volatile("" ::: "memory");
        }
    }
};

template <class Epi, class Sched, bool ALIGN_EPI = false, bool SP2 = false>
__device__ __forceinline__ void gemm_phase(PG8_LAS unsigned char* lds, const Gemm g, const Sched& S, const Epi& E) {
    int tid_ = threadIdx.x; asm volatile("" : "+v"(tid_));
    const int tid = tid_, wid = __builtin_amdgcn_readfirstlane(tid >> 6), lane = tid & 63, wr = wid >> 2, wc = wid & 3, fr = lane & 15, fq = lane >> 4;
    const int K = g.K, nt = K / BK, LD = g.ld ? g.ld : g.K;
    unsigned voffA[2], voffB[2];
#pragma unroll
    for (int i = 0; i < 2; ++i) { int R, C; stage_rc(tid * 16 + i * 8192, R, C); const int Rb = Epi::PERM ? ((R & ~31) + perm32(R & 31)) : R;
        voffA[i] = (unsigned)(R * LD + C) * 2u; voffB[i] = (unsigned)(Rb * LD + C) * 2u; }
    const size_t kstep = (size_t)(BK * 2);
    const size_t hstep = (size_t)HALF * LD * 2;
    const size_t tstep = 2 * hstep;
    const unsigned ldsw = (unsigned)wid * 1024u;
    const int aoff = lds_byte(wr * 64 + fr, fq * 8), boff = lds_byte(wc * 32 + fr, fq * 8);
#define PG8_SA(b, h) (((b) * 2 + (h)) * HTB)
#define PG8_SB(b, h) ((4 + (b) * 2 + (h)) * HTB)
#define PG8_STAGE(bufoff, gbase, voff) do { _Pragma("unroll") for (int _i = 0; _i < 2; ++_i) \
        __builtin_amdgcn_global_load_lds((const unsigned*)((const char*)(gbase) + (voff)[_i]), (PG8_LAS unsigned*)(lds + (bufoff) + ldsw + _i * 8192), 16, 0, 0); } while (0)
#define PG8_LDA(dst, b, h) do { _Pragma("unroll") for (int m = 0; m < 4; ++m) _Pragma("unroll") for (int k = 0; k < 2; ++k) dst[m][k] = *(const PG8_LAS bf16x8*)(lds + PG8_SA(b, h) + aoff + m * 2048 + k * 1024); } while (0)
#define PG8_LDB(dst, b, h) do { _Pragma("unroll") for (int n = 0; n < 2; ++n) _Pragma("unroll") for (int k = 0; k < 2; ++k) dst[n][k] = *(const PG8_LAS bf16x8*)(lds + PG8_SB(b, h) + boff + n * 2048 + k * 1024); } while (0)
#define PG8_MMA(ai, bj, At, Bt) do { __builtin_amdgcn_s_setprio(1); _Pragma("unroll") for (int m = 0; m < 4; ++m) _Pragma("unroll") for (int n = 0; n < 2; ++n) _Pragma("unroll") for (int k = 0; k < 2; ++k) \
        acc[ai][bj][m][n] = __builtin_amdgcn_mfma_f32_16x16x32_bf16(Bt[n][k], At[m][k], acc[ai][bj][m][n], 0, 0, 0); __builtin_amdgcn_s_setprio(0); } while (0)
#define PG8_WAIT_V(n) asm volatile("s_waitcnt vmcnt(" #n ")" ::: "memory")
#define PG8_WAIT_L(n) asm volatile("s_waitcnt lgkmcnt(" #n ")" ::: "memory")
#define PG8_BAR __builtin_amdgcn_s_barrier()
#define PG8_SCHED __builtin_amdgcn_sched_barrier(0)
    Unit cur, nxt; int ui = 0;
    if (!S.next(0, cur)) return;
    f32x4 acc[2][2][4][2];
#pragma unroll
    for (int a = 0; a < 2; ++a)
#pragma unroll
        for (int b = 0; b < 2; ++b)
#pragma unroll
            for (int m = 0; m < 4; ++m)
#pragma unroll
                for (int n = 0; n < 2; ++n) acc[a][b][m][n] = (f32x4){0.f, 0.f, 0.f, 0.f};
    bf16x8 At[4][2], B0[2][2], B1[2][2];
    const long rowb = (long)LD * 2;
    const char* cA = (const char*)g.A + S.arow(cur.pm) * rowb; const char* cB = (const char*)g.Bt + (size_t)cur.pn * tstep;
    S.a_ready(cur);
    if constexpr (SP2) {
        PG8_STAGE(PG8_SB(0, 0), cB, voffB); PG8_STAGE(PG8_SB(0, 1), cB + hstep, voffB); PG8_STAGE(PG8_SA(0, 0), cA, voffA); PG8_STAGE(PG8_SA(0, 1), cA + hstep, voffA);
        if (wr == 1) PG8_BAR;
        PG8_WAIT_V(2); PG8_BAR;
        PG8_STAGE(PG8_SB(1, 0), cB + kstep, voffB); PG8_STAGE(PG8_SA(1, 0), cA + kstep, voffA); PG8_STAGE(PG8_SB(1, 1), cB + hstep + kstep, voffB);
        PG8_WAIT_V(6); PG8_BAR;
    } else {
        PG8_STAGE(PG8_SB(0, 0), cB, voffB); PG8_STAGE(PG8_SA(0, 0), cA, voffA); PG8_STAGE(PG8_SB(0, 1), cB + hstep, voffB); PG8_STAGE(PG8_SA(0, 1), cA + hstep, voffA);
        if (wr == 1) PG8_BAR;
        PG8_WAIT_V(4); PG8_BAR;
        PG8_STAGE(PG8_SB(1, 0), cB + kstep, voffB); PG8_STAGE(PG8_SA(1, 0), cA + kstep, voffA); PG8_STAGE(PG8_SB(1, 1), cB + hstep + kstep, voffB);
        PG8_WAIT_V(6); PG8_BAR;
    }
    for (;;) {
        const bool has_next = S.next(ui + 1, nxt);
        const char* nA = has_next ? (const char*)g.A + S.arow(nxt.pm) * rowb : cA; const char* nB = has_next ? (const char*)g.Bt + (size_t)nxt.pn * tstep : cB;
        for (int t = 0; t < nt; t += 2) {
            const bool last = (t == nt - 2);
            const char* a1 = cA + (size_t)(t + 1) * kstep;
            const char* a2 = last ? nA : cA + (size_t)(t + 2) * kstep; const char* b2 = last ? nB : cB + (size_t)(t + 2) * kstep;
            const char* a3 = a2 + kstep; const char* b3 = b2 + kstep;
            if (last && has_next) S.a_ready(nxt);
            if constexpr (SP2) {
            PG8_LDB(B0, 0, 0); PG8_LDB(B1, 0, 1); PG8_SCHED; PG8_LDA(At, 0, 0); PG8_STAGE(PG8_SA(1, 1), a1 + hstep, voffA);
            PG8_WAIT_V(8); PG8_WAIT_L(0); PG8_BAR; PG8_MMA(0, 0, At, B0); PG8_MMA(0, 1, At, B1); PG8_BAR; PG8_SCHED;
            PG8_LDA(At, 0, 1); PG8_STAGE(PG8_SB(0, 0), b2, voffB); PG8_STAGE(PG8_SB(0, 1), b2 + hstep, voffB); PG8_STAGE(PG8_SA(0, 0), a2, voffA);
            PG8_WAIT_V(8); PG8_WAIT_L(0); PG8_BAR; PG8_MMA(1, 0, At, B0); PG8_MMA(1, 1, At, B1); PG8_BAR; PG8_SCHED;
            PG8_LDB(B0, 1, 0); PG8_LDB(B1, 1, 1); PG8_SCHED; PG8_LDA(At, 1, 0); PG8_STAGE(PG8_SA(0, 1), a2 + hstep, voffA);
            PG8_WAIT_V(8); PG8_WAIT_L(0); PG8_BAR; PG8_MMA(0, 0, At, B0); PG8_MMA(0, 1, At, B1); PG8_BAR; PG8_SCHED;
            PG8_LDA(At, 1, 1); PG8_STAGE(PG8_SB(1, 0), b3, voffB); PG8_STAGE(PG8_SB(1, 1), b3 + hstep, voffB); PG8_STAGE(PG8_SA(1, 0), a3, voffA);
            PG8_WAIT_V(8); PG8_WAIT_L(0); PG8_BAR; PG8_MMA(1, 0, At, B0); PG8_MMA(1, 1, At, B1); PG8_BAR; PG8_SCHED;
            } else {
            PG8_LDB(B0, 0, 0); PG8_SCHED; PG8_LDA(At, 0, 0); PG8_STAGE(PG8_SA(1, 1), a1 + hstep, voffA);
            PG8_WAIT_L(8); PG8_BAR; PG8_WAIT_L(0); PG8_MMA(0, 0, At, B0); PG8_BAR; PG8_SCHED;
            PG8_LDB(B1, 0, 1); PG8_STAGE(PG8_SB(0, 0), b2, voffB);
            PG8_BAR; PG8_WAIT_L(0); PG8_MMA(0, 1, At, B1); PG8_BAR;
            PG8_LDA(At, 0, 1); PG8_STAGE(PG8_SA(0, 0), a2, voffA);
            PG8_BAR; PG8_WAIT_L(0); PG8_MMA(1, 0, At, B0); PG8_BAR; PG8_SCHED;
            PG8_STAGE(PG8_SB(0, 1), b2 + hstep, voffB);
            PG8_WAIT_V(6); PG8_BAR; PG8_MMA(1, 1, At, B1); PG8_BAR;
            PG8_LDB(B0, 1, 0); PG8_SCHED; PG8_LDA(At, 1, 0); PG8_STAGE(PG8_SA(0, 1), a2 + hstep, voffA);
            PG8_WAIT_L(8); PG8_BAR; PG8_WAIT_L(0); PG8_MMA(0, 0, At, B0); PG8_BAR; PG8_SCHED;
            PG8_LDB(B1, 1, 1); PG8_STAGE(PG8_SB(1, 0), b3, voffB);
            PG8_BAR; PG8_WAIT_L(0); PG8_MMA(0, 1, At, B1); PG8_BAR;
            PG8_LDA(At, 1, 1); PG8_STAGE(PG8_SA(1, 0), a3, voffA);
            PG8_BAR; PG8_WAIT_L(0); PG8_MMA(1, 0, At, B0); PG8_BAR; PG8_SCHED;
            PG8_STAGE(PG8_SB(1, 1), b3 + hstep, voffB);
            PG8_WAIT_V(6); PG8_BAR; PG8_MMA(1, 1, At, B1); PG8_BAR;
            }
        }
        if constexpr (ALIGN_EPI) { if (wr == 0) PG8_BAR; }
        if constexpr (!Epi::AFTER_DRAIN) { E(acc, cur, wr, wc, fr, fq); S.done(cur); }
        if (!has_next) break;
#pragma unroll
        for (int a = 0; a < 2; ++a)
#pragma unroll
            for (int b = 0; b < 2; ++b)
#pragma unroll
                for (int m = 0; m < 4; ++m)
#pragma unroll
                    for (int n = 0; n < 2; ++n) acc[a][b][m][n] = (f32x4){0.f, 0.f, 0.f, 0.f};
        cur = nxt; cA = nA; cB = nB; ++ui;
        if constexpr (ALIGN_EPI) { if (wr == 1) PG8_BAR; }
    }
    PG8_WAIT_V(0);
    if constexpr (!ALIGN_EPI) { if (wr == 0) PG8_BAR; }
    PG8_BAR;
    if constexpr (Epi::AFTER_DRAIN) { E.fused(acc, cur, wr, wc, fr, fq, lds, wid, lane); S.done(cur); }
#undef PG8_SA
#undef PG8_SB
#undef PG8_STAGE
#undef PG8_LDA
#undef PG8_LDB
#undef PG8_MMA
#undef PG8_WAIT_V
#undef PG8_WAIT_L
#undef PG8_BAR
#undef PG8_SCHED
}
}
typedef unsigned short bf16;
typedef short bf16x8 __attribute__((ext_vector_type(8)));
typedef float f32x4 __attribute__((ext_vector_type(4)));
typedef float f32x2 __attribute__((ext_vector_type(2)));
typedef float f32x16 __attribute__((ext_vector_type(16)));
typedef unsigned v4u __attribute__((ext_vector_type(4)));
typedef unsigned v2u __attribute__((ext_vector_type(2)));

constexpr int D = 1024, NB = 4, SEQ = 8192, CTXL = 256, MLAT = 32768, MCTX = 1024, MALL = 33792;
constexpr int INW = 2080, INP = 2304, DFF = 2816, DFF2 = 5632;
constexpr int C_GQ = 0, C_GK = 192, C_GV = 384, C_GG = 768, C_ZF = 1152, C_ZB = 1168, C_AQ = 1184, C_AK = 1568, C_AV = 1696, C_PU = 1824;
constexpr float EPS = 1e-6f;
constexpr size_t MiB = (size_t)1 << 20;
constexpr size_t WS_PWT = 1 * MiB + 512 * 1024;
constexpr size_t WS_MOD = 1 * MiB, WS_WIN = 2 * MiB, WS_WOUT = 11 * MiB, WS_WUP = 15 * MiB, WS_WDN = 37 * MiB, WS_CTX = 48 * MiB, WS_H = 52 * MiB,
                 WS_P = 120 * MiB, WS_MIX = 270 * MiB, WS_ST = 336 * MiB, WS_DEC = 411 * MiB, WS_SI = 416 * MiB  , WS_U = 120 * MiB, WS_ACT = 300 * MiB, WS_PART = 484 * MiB, WS_END = 500 * MiB;
constexpr size_t U_CHUNK_ELEMS = (size_t)8192 * 5632;
constexpr int LDS_BYTES = 163840;
constexpr int XB_OFF = 139264, CTRL_OFF = 155648;
constexpr int NCH = 132;

struct KP { const float* in[22]; float* out; unsigned char* ws; };
constexpr int PTAB_OFF = CTRL_OFF + 1024;
struct KPD {
    unsigned char* lds;
    __device__ __forceinline__ unsigned long long ld(int i) const { const unsigned long long v = *(const volatile __attribute__((address_space(3))) unsigned long long*)(unsigned)(PTAB_OFF + 8 * i);
        const unsigned lo = __builtin_amdgcn_readfirstlane((unsigned)v), hi = __builtin_amdgcn_readfirstlane((unsigned)(v >> 32)); return ((unsigned long long)hi << 32) | lo; }
    __device__ __forceinline__ const float* in(int i) const { return (const float*)(const __attribute__((address_space(1))) float*)ld(i); }
    __device__ __forceinline__ float* out() const { return (float*)(__attribute__((address_space(1))) float*)ld(22); }
    __device__ __forceinline__ unsigned char* ws() const { return (unsigned char*)(__attribute__((address_space(1))) unsigned char*)ld(23); }
};
enum { I_X = 0, I_C, I_CTX, I_CCTX, I_WADA, I_BADA, I_N1G, I_WIN, I_GWDEC, I_GBDEC, I_GNG, I_QNG, I_KNG, I_SINK, I_POOLW, I_POOLS, I_WOUT, I_N2G, I_WUP, I_CONVW, I_CONVB, I_WDOWN };

typedef short v4i16_t __attribute__((ext_vector_type(4)));
typedef float f32x2c_t __attribute__((ext_vector_type(2))); typedef __bf16 bf16x2c_t __attribute__((ext_vector_type(2)));
__device__ __forceinline__ unsigned cvtpk_b(float lo, float hi) { f32x2c_t v = {lo, hi}; bf16x2c_t b = __builtin_convertvector(v, bf16x2c_t); return __builtin_bit_cast(unsigned, b); }
#define LASP __attribute__((address_space(3)))
__device__ __forceinline__ unsigned cvtpk(float lo, float hi) { unsigned r; asm("v_cvt_pk_bf16_f32 %0, %1, %2" : "=v"(r) : "v"(lo), "v"(hi)); return r; }
__device__ __forceinline__ bf16x8 tr8(const unsigned short* lo_p, int hi_off) { const LASP unsigned short* p = (const LASP unsigned short*)lo_p;
    const v4i16_t lo = __builtin_amdgcn_ds_read_tr16_b64_v4i16((LASP v4i16_t*)p), hi = __builtin_amdgcn_ds_read_tr16_b64_v4i16((LASP v4i16_t*)(p + hi_off));
    return (bf16x8){lo[0], lo[1], lo[2], lo[3], hi[0], hi[1], hi[2], hi[3]}; }
__device__ __forceinline__ float bf2f(unsigned h) { return __uint_as_float(h << 16); }
__device__ __forceinline__ unsigned f2bf(float f) { unsigned u = __float_as_uint(f); return (u + 0x7fffu + ((u >> 16) & 1u)) >> 16; }
__device__ __forceinline__ unsigned pk2(float lo, float hi) { return cvtpk(lo, hi); }
__device__ __forceinline__ float lo16(unsigned w) { return __uint_as_float(w << 16); }
__device__ __forceinline__ float hi16(unsigned w) { return __uint_as_float(w & 0xffff0000u); }
__device__ __forceinline__ float silu_f(float x) { return x * __builtin_amdgcn_rcpf(1.f + __expf(-x)); }
#define LDS_WAIT() asm volatile("s_waitcnt lgkmcnt(0)" ::: "memory")
__device__ __forceinline__ float wave_sum(float v) {
#pragma unroll
    for (int o = 1; o < 64; o <<= 1) v += __shfl_xor(v, o);
    return v;
}

template <bool UPMAP>
__device__ __forceinline__ void transpose_item(const float* W, int K, int N, bf16* WT, float* scr, int item, int lane) {
    const int nblk = N / 32, kb = item / nblk, nb = item % nblk, k0 = 64 * kb, n0 = 32 * nb;
    { f32x4 v[8];
#pragma unroll
      for (int i = 0; i < 8; ++i) v[i] = *(const f32x4*)(W + (size_t)(k0 + 8 * i + (lane >> 3)) * N + n0 + 4 * (lane & 7));
#pragma unroll
      for (int i = 0; i < 8; ++i) { float* d = scr + (8 * i + (lane >> 3)) * 33 + 4 * (lane & 7); d[0] = v[i][0]; d[1] = v[i][1]; d[2] = v[i][2]; d[3] = v[i][3]; } }
    LDS_WAIT();
    const int c = lane & 7;
#pragma unroll
    for (int j = 0; j < 4; ++j) { const int n = (lane >> 3) + 8 * j; const float* s = scr + (8 * c) * 33 + n;
        v4u o; o.x = pk2(s[0 * 33], s[1 * 33]); o.y = pk2(s[2 * 33], s[3 * 33]); o.z = pk2(s[4 * 33], s[5 * 33]); o.w = pk2(s[6 * 33], s[7 * 33]);
        const int nsrc = n0 + n; int nrow = nsrc;
        if (UPMAP) { const int bj = nsrc / 2816, chn = nsrc - bj * 2816; nrow = (chn >> 7) * 256 + bj * 128 + (chn & 127); }
        *(v4u*)(WT + (size_t)nrow * K + k0 + 8 * c) = o; }
    LDS_WAIT();
}

template <int PART>
__device__ __forceinline__ void prologue(const KPD& kp, unsigned char* lds, int tid, int lane, int wave) {
    unsigned char* ws = kp.ws();
    float* scr = (float*)(lds + wave * 16384);
    const int gw = blockIdx.x * 8 + wave, NGW = gridDim.x * 8;
    constexpr int I_IN = 16 * 65, I_OUT = 16 * 32, I_UP = 16 * 176, I_DN = 44 * 32, PER = I_IN + I_OUT + I_UP + I_DN;
    if constexpr (PART == 1) {
    for (int it = gw; it < 2 * PER; it += NGW) {
        const int l = it / PER; int r = it % PER;
        if (r < I_IN) { transpose_item<false>(kp.in(I_WIN) + (size_t)l * D * INW, D, INW, (bf16*)(ws + WS_WIN) + (size_t)l * INP * D, scr, r, lane); continue; } r -= I_IN;
        if (r < I_OUT) { transpose_item<false>(kp.in(I_WOUT) + (size_t)l * D * D, D, D, (bf16*)(ws + WS_WOUT) + (size_t)l * D * D, scr, r, lane); continue; } r -= I_OUT;
        if (r < I_UP) { transpose_item<true>(kp.in(I_WUP) + (size_t)l * D * DFF2, D, DFF2, (bf16*)(ws + WS_WUP) + (size_t)l * DFF2 * D, scr, r, lane); continue; } r -= I_UP;
        transpose_item<false>(kp.in(I_WDOWN) + (size_t)l * DFF * D, DFF, D, (bf16*)(ws + WS_WDN) + (size_t)l * D * DFF, scr, r, lane);
    }
    { const int gt = blockIdx.x * 512 + tid, NT = gridDim.x * 512; constexpr int PADV = (INP - INW) * D * 2 / 16;
      for (int i = gt; i < 2 * PADV; i += NT) { const int l = i / PADV, r = i % PADV; *((v4u*)((bf16*)(ws + WS_WIN) + (size_t)l * INP * D + (size_t)INW * D) + r) = (v4u){0u, 0u, 0u, 0u}; } }
    __syncthreads();
    return;
    }
    { const int gt = blockIdx.x * 512 + tid;
      if (gt < 32768) { const int k = gt & 63, nn = (gt >> 6) & 63, lg = gt >> 12; ((bf16*)(ws + WS_PWT))[gt] = (bf16)f2bf(kp.in(I_POOLW)[(size_t)(lg * 64 + k) * 64 + nn]); } }
    { const int gt = blockIdx.x * 512 + tid, NT = gridDim.x * 512;
      for (int i = gt; i < MCTX * D / 4; i += NT) ((f32x4*)(ws + WS_CTX))[i] = ((const f32x4*)kp.in(I_CTX))[i]; }
    __syncthreads();
    float* cs = (float*)lds; float* red = cs + 5 * 1024;
    for (int item = blockIdx.x; item < 192; item += gridDim.x) {
        const int l = item / 96, n0 = (item % 96) * 64;
        for (int i = tid; i < 5 * 1024; i += 512) { const float v = (i < 4096) ? kp.in(I_C)[i] : kp.in(I_CCTX)[i - 4096]; cs[i] = silu_f(v); }
        __syncthreads();
        float a0 = 0.f, a1 = 0.f, a2 = 0.f, a3 = 0.f, a4 = 0.f;
        const float* w = kp.in(I_WADA) + (size_t)l * D * 6144 + n0 + lane;
        for (int k = wave * 128; k < wave * 128 + 128; ++k) { const float wv = w[(size_t)k * 6144];
            a0 += cs[k] * wv; a1 += cs[1024 + k] * wv; a2 += cs[2048 + k] * wv; a3 += cs[3072 + k] * wv; a4 += cs[4096 + k] * wv; }
        red[(wave * 5 + 0) * 64 + lane] = a0; red[(wave * 5 + 1) * 64 + lane] = a1; red[(wave * 5 + 2) * 64 + lane] = a2; red[(wave * 5 + 3) * 64 + lane] = a3; red[(wave * 5 + 4) * 64 + lane] = a4;
        __syncthreads();
        if (tid < 320) { const int r = tid / 64, c = tid % 64; float s = 0.f;
#pragma unroll
            for (int w8 = 0; w8 < 8; ++w8) s += red[(w8 * 5 + r) * 64 + c];
            ((float*)(ws + WS_MOD))[(size_t)(l * 5 + r) * 6144 + n0 + c] = s + kp.in(I_BADA)[l * 6144 + n0 + c]; }
        __syncthreads();
    }
}

template <int NR>
__device__ __forceinline__ void norm_group(int m0, const float* src_lat, const float* src_ctx, bf16* H, const float* gain, const float* mod, int shoff, int scoff, int lane, const float* part, float* ctx_out) {
    const float* xr = (m0 < MLAT) ? src_lat + (size_t)m0 * D : src_ctx + (size_t)(m0 - MLAT) * D;
    const int b = (m0 < MLAT) ? (m0 >> 13) : 4;
    f32x4 v[NR][4]; float rstd[NR];
#pragma unroll
    for (int i = 0; i < NR; ++i)
#pragma unroll
        for (int j = 0; j < 4; ++j) v[i][j] = *((const f32x4*)(xr + (size_t)i * D) + lane + 64 * j);
    if (part && m0 >= MLAT) {
#pragma unroll
        for (int i = 0; i < NR; ++i)
#pragma unroll
            for (int j = 0; j < 4; ++j) { const size_t o = (size_t)(m0 - MLAT + i) * D + 4 * (lane + 64 * j);
                const f32x4 p0 = *(const f32x4*)(part + o), p1 = *(const f32x4*)(part + (size_t)MCTX * D + o), p2 = *(const f32x4*)(part + (size_t)2 * MCTX * D + o), p3 = *(const f32x4*)(part + (size_t)3 * MCTX * D + o);
                v[i][j] = v[i][j] + ((p0 + p1) + (p2 + p3)); *(f32x4*)(ctx_out + o) = v[i][j]; }
    }
#pragma unroll
    for (int i = 0; i < NR; ++i) { float s = 0.f;
#pragma unroll
        for (int j = 0; j < 4; ++j) s += (v[i][j].x * v[i][j].x + v[i][j].y * v[i][j].y) + (v[i][j].z * v[i][j].z + v[i][j].w * v[i][j].w);
        rstd[i] = 1.0f / sqrtf(wave_sum(s) * (1.f / D) + EPS); }
    const float* mr = mod + b * 6144;
#pragma unroll
    for (int j = 0; j < 4; ++j) { const int idx = 4 * (lane + 64 * j);
        const f32x4 g = *(const f32x4*)(gain + idx), sc = *(const f32x4*)(mr + scoff + idx), sh = *(const f32x4*)(mr + shoff + idx);
        const f32x4 gs = g * (1.f + sc);
#pragma unroll
        for (int i = 0; i < NR; ++i) { const f32x4 y = v[i][j] * rstd[i] * gs + sh;
            v2u o; o.x = pk2(y.x, y.y); o.y = pk2(y.z, y.w);
            *(v2u*)(H + (size_t)(m0 + i) * D + idx) = o; } }
}
__device__ __forceinline__ void norm_pass(const float* src_lat, const float* src_ctx, bf16* H, const float* gain, const float* mod, int shoff, int scoff, int nrows, int lane, int wave, const float* part = nullptr, float* ctx_out = nullptr) {
    const int gw = blockIdx.x * 8 + wave, NGW = gridDim.x * 8;
    for (int q = gw; q < MLAT / 4; q += NGW) norm_group<4>(4 * q, src_lat, src_ctx, H, gain, mod, shoff, scoff, lane, part, ctx_out);
    for (int m = MLAT + gw; m < nrows; m += NGW) norm_group<1>(m, src_lat, src_ctx, H, gain, mod, shoff, scoff, lane, part, ctx_out);
}

template <int CTRL> __device__ __forceinline__ float dppf(float x) { return __builtin_bit_cast(float, __builtin_amdgcn_update_dpp(0, __builtin_bit_cast(int, x), CTRL, 0xf, 0xf, false)); }
__device__ __forceinline__ float row16_max(float v) { v = fmaxf(v, dppf<0xB1>(v)); v = fmaxf(v, dppf<0x4E>(v)); v = fmaxf(v, dppf<0x141>(v)); v = fmaxf(v, dppf<0x128>(v)); return v; }
__device__ __forceinline__ float row16_sum(float v) { v += dppf<0xB1>(v); v += dppf<0x4E>(v); v += dppf<0x141>(v); v += dppf<0x128>(v); return v; }
__device__ __forceinline__ void chunk_coords(int sc, int& b, int& n, int& rowbase) {
    if (sc < 512) { b = sc >> 7; n = sc & 127; rowbase = b * SEQ + n * 64; }
    else { const int j = sc - 512; b = j >> 2; n = 128 + (j & 3); rowbase = MLAT + b * CTXL + (j & 3) * 64; }
}
__device__ __forceinline__ float wave_incl_scan(float v) {
    v += __builtin_bit_cast(float, __builtin_amdgcn_update_dpp(0, __builtin_bit_cast(int, v), 0x111, 0xf, 0xf, true));
    v += __builtin_bit_cast(float, __builtin_amdgcn_update_dpp(0, __builtin_bit_cast(int, v), 0x112, 0xf, 0xf, true));
    v += __builtin_bit_cast(float, __builtin_amdgcn_update_dpp(0, __builtin_bit_cast(int, v), 0x114, 0xf, 0xf, true));
    v += __builtin_bit_cast(float, __builtin_amdgcn_update_dpp(0, __builtin_bit_cast(int, v), 0x118, 0xf, 0xf, true));
    v += __builtin_bit_cast(float, __builtin_amdgcn_update_dpp(0, __builtin_bit_cast(int, v), 0x142, 0xa, 0xf, false));
    v += __builtin_bit_cast(float, __builtin_amdgcn_update_dpp(0, __builtin_bit_cast(int, v), 0x143, 0xc, 0xf, false));
    return v;
}
__device__ __forceinline__ void gla_prefetch(v4u& pz0, v4u& pz1, v4u& pw0, v4u& pw1, const KPD& kp, int l, int pair, int lane, int wave) {
    const int half = wave >> 2, w4 = wave & 3, item = 2 * pair + half, h = item & 3, sc = item >> 2; int b, n, rowbase; chunk_coords(sc, b, n, rowbase);
    const int dir = w4 >> 1, d0 = 24 * (w4 & 1);
    const bf16* prow = (const bf16*)(kp.ws() + WS_P) + (size_t)(rowbase + lane) * INP;
    pz0 = *(const v4u*)(prow + (dir ? C_ZB : C_ZF)); pz1 = *(const v4u*)(prow + (dir ? C_ZB : C_ZF) + 8);
    const float* W = kp.in(I_GWDEC) + (size_t)((l * 2 + dir) * 16) * 192 + h * 48 + d0;
    const float* bias = kp.in(I_GBDEC) + (l * 2 + dir) * 192 + h * 48 + d0;
    unsigned w[6];
#pragma unroll
    for (int i = 0; i < 6; ++i) { const int e = lane + 64 * i; w[i] = __float_as_uint(W[(e / 24) * 192 + (e % 24)]); }
    pw0 = (v4u){w[0], w[1], w[2], w[3]}; pw1 = (v4u){w[4], w[5], __float_as_uint(bias[lane < 24 ? lane : 0]), 0u};
}
template <bool PHC>
__device__ __forceinline__ void gla_pair(const KPD& kp, int l, int pair, unsigned char* lds, int tid, int lane, int wave, v4u& pz0, v4u& pz1, v4u& pw0, v4u& pw1, int next_pair) {
    const int half = wave >> 2, w4 = wave & 3, t4 = tid & 255;
    const int item = 2 * pair + half;
    const int h = item & 3, sc = item >> 2; int b, n, rowbase; chunk_coords(sc, b, n, rowbase);
    unsigned char* L = lds + half * 69632;
    const bf16* P = (const bf16*)(kp.ws() + WS_P);
    float* ST = (float*)(kp.ws() + WS_ST); float* DEC = (float*)(kp.ws() + WS_DEC);
    const int dir = w4 >> 1, d0 = 24 * (w4 & 1);
    const bf16* prow = P + (size_t)(rowbase + lane) * INP;
    v4u vpre[3];
#pragma unroll
    for (int i = 0; i < 3; ++i) { const int idx = t4 + 256 * i; vpre[i] = *(const v4u*)(P + (size_t)(rowbase + idx / 12) * INP + C_GV + h * 96 + 8 * (idx % 12)); }
    v2u spre[9];
    if constexpr (PHC) { const bf16* SI = (const bf16*)(kp.ws() + WS_SI);
#pragma unroll
        for (int i = 0; i < 9; ++i) { const int idx = t4 + 256 * i; const int dd = idx / 1152, e = (idx % 1152) * 4;
            spre[i] = *(const v2u*)(SI + ((size_t)((dd * 4 + b) * NCH + n) * 4 + h) * 4608 + e); }
    }
    float z[16];
    { const v4u z0 = pz0, z1 = pz1;
      z[0] = lo16(z0.x); z[1] = hi16(z0.x); z[2] = lo16(z0.y); z[3] = hi16(z0.y); z[4] = lo16(z0.z); z[5] = hi16(z0.z); z[6] = lo16(z0.w); z[7] = hi16(z0.w);
      z[8] = lo16(z1.x); z[9] = hi16(z1.x); z[10] = lo16(z1.y); z[11] = hi16(z1.y); z[12] = lo16(z1.z); z[13] = hi16(z1.z); z[14] = lo16(z1.w); z[15] = hi16(z1.w); }
    v4u qraw[3], kraw[3];
#pragma unroll
    for (int i = 0; i < 3; ++i) { qraw[i] = *((const v4u*)(prow + C_GQ + h * 48 + d0) + i); kraw[i] = *((const v4u*)(prow + C_GK + h * 48 + d0) + i); }
    const int wvv[6] = {(int)pw0.x, (int)pw0.y, (int)pw0.z, (int)pw0.w, (int)pw1.x, (int)pw1.y};
    const int bvv = (int)pw1.z;
    float bc[24], tot[24];
#pragma unroll
    for (int c = 0; c < 24; ++c) {
        float pre = __int_as_float(__builtin_amdgcn_readlane(bvv, c));
#pragma unroll
        for (int r = 0; r < 16; ++r) pre += z[r] * __int_as_float(__builtin_amdgcn_readlane(wvv[(24 * r + c) >> 6], (24 * r + c) & 63));
        const float la = (fminf(pre, 0.f) - __logf(1.f + __expf(-fabsf(pre)))) * (1.f / 16.f);
        const float inc = wave_incl_scan(la);
        const float total = __int_as_float(__builtin_amdgcn_readlane(__float_as_int(inc), 63));
        bc[c] = dir ? (total - inc + la) : inc; tot[c] = total;
    }
    float qv[24], kv[24];
#pragma unroll
    for (int i = 0; i < 3; ++i) {
        qv[8 * i] = lo16(qraw[i].x); qv[8 * i + 1] = hi16(qraw[i].x); qv[8 * i + 2] = lo16(qraw[i].y); qv[8 * i + 3] = hi16(qraw[i].y);
        qv[8 * i + 4] = lo16(qraw[i].z); qv[8 * i + 5] = hi16(qraw[i].z); qv[8 * i + 6] = lo16(qraw[i].w); qv[8 * i + 7] = hi16(qraw[i].w);
        kv[8 * i] = lo16(kraw[i].x); kv[8 * i + 1] = hi16(kraw[i].x); kv[8 * i + 2] = lo16(kraw[i].y); kv[8 * i + 3] = hi16(kraw[i].y);
        kv[8 * i + 4] = lo16(kraw[i].z); kv[8 * i + 5] = hi16(kraw[i].z); kv[8 * i + 6] = lo16(kraw[i].w); kv[8 * i + 7] = hi16(kraw[i].w); }
    const size_t stbase = (size_t)((dir * 4 + b) * NCH + n);
    if constexpr (!PHC) {
        bf16* Vr = (bf16*)L;
        bf16* KE = (bf16*)(L + 13312);
        { unsigned kw[12];
#pragma unroll
          for (int i = 0; i < 12; ++i) kw[i] = pk2(kv[2 * i] * __expf(tot[2 * i] - bc[2 * i]), kv[2 * i + 1] * __expf(tot[2 * i + 1] - bc[2 * i + 1]));
          v4u* ko = (v4u*)(KE + (dir * 64 + lane) * 56 + d0);
#pragma unroll
          for (int i = 0; i < 3; ++i) ko[i] = (v4u){kw[4 * i], kw[4 * i + 1], kw[4 * i + 2], kw[4 * i + 3]}; }
        if (lane == 0) {
#pragma unroll
            for (int c = 0; c < 24; ++c) DEC[stbase * 192 + h * 48 + d0 + c] = __expf(tot[c]);
        }
#pragma unroll
        for (int i = 0; i < 3; ++i) { const int idx = t4 + 256 * i; const int t = idx / 12, ch = idx % 12; *(v4u*)(Vr + t * 104 + 8 * ch) = vpre[i]; }
        __syncthreads();
        if (next_pair >= 0) gla_prefetch(pz0, pz1, pw0, pw1, kp, l, next_pair, lane, wave);
        const int fr = lane & 15, fq = lane >> 4, q4 = fr >> 2, p4 = lane & 3;
#pragma unroll 1
        for (int ti = (w4 & 1); ti < 18; ti += 2) { const int vt = ti / 3, dt = ti % 3;
            f32x4 acc = {0.f, 0.f, 0.f, 0.f};
#pragma unroll
            for (int ks = 0; ks < 2; ++ks) {
                const bf16x8 a = tr8(Vr + (32 * ks + 8 * fq + q4) * 104 + 16 * vt + 4 * p4, 4 * 104);
                const bf16x8 bb = tr8(KE + (dir * 64 + 32 * ks + 8 * fq + q4) * 56 + 16 * dt + 4 * p4, 4 * 56);
                acc = __builtin_amdgcn_mfma_f32_16x16x32_bf16(a, bb, acc, 0, 0, 0); }
            *(v2u*)((bf16*)ST + (stbase * 4 + h) * 4608 + (size_t)(16 * dt + fr) * 96 + 16 * vt + 4 * fq) = (v2u){cvtpk_b(acc[0], acc[1]), cvtpk_b(acc[2], acc[3])}; }
    } else {
        bf16* AC = (bf16*)L;
        bf16* Vr = (bf16*)(L + 21504);
        bf16* SB = (bf16*)(L + 34816);
        bf16* KI = (bf16*)(L + 54784);
        const float qs = 0.14433756729740643f;
        { unsigned qw[12], kw[12];
#pragma unroll
          for (int i = 0; i < 12; ++i) { qw[i] = pk2(qv[2 * i] * qs * __expf(bc[2 * i]), qv[2 * i + 1] * qs * __expf(bc[2 * i + 1])); kw[i] = pk2(kv[2 * i] * __expf(-bc[2 * i]), kv[2 * i + 1] * __expf(-bc[2 * i + 1])); }
          v4u* qo = (v4u*)(AC + lane * 168 + 64 + dir * 48 + d0); v4u* ko = (v4u*)(KI + (dir * 64 + lane) * 56 + d0);
#pragma unroll
          for (int i = 0; i < 3; ++i) { qo[i] = (v4u){qw[4 * i], qw[4 * i + 1], qw[4 * i + 2], qw[4 * i + 3]}; ko[i] = (v4u){kw[4 * i], kw[4 * i + 1], kw[4 * i + 2], kw[4 * i + 3]}; } }
#pragma unroll
        for (int i = 0; i < 3; ++i) { const int idx = t4 + 256 * i; const int t = idx / 12, ch = idx % 12; *(v4u*)(Vr + t * 104 + 8 * ch) = vpre[i]; }
#pragma unroll
        for (int i = 0; i < 9; ++i) { const int idx = t4 + 256 * i; const int dd = idx / 1152, e = (idx % 1152) * 4, d = e / 96, v = e % 96;
            *(v2u*)(SB + (dd * 48 + d) * 104 + v) = spre[i]; }
        __syncthreads();
        { const int rt = w4 >> 1, ct = w4 & 1, r32 = lane & 31, hi = lane >> 5;
          f32x16 af, ab;
#pragma unroll
          for (int r = 0; r < 16; ++r) { af[r] = 0.f; ab[r] = 0.f; }
#pragma unroll
          for (int ks = 0; ks < 3; ++ks) {
              const bf16x8 a0 = *(const bf16x8*)(AC + (32 * rt + r32) * 168 + 64 + 16 * ks + 8 * hi);
              const bf16x8 b0 = *(const bf16x8*)(KI + (32 * ct + r32) * 56 + 16 * ks + 8 * hi);
              af = __builtin_amdgcn_mfma_f32_32x32x16_bf16(a0, b0, af, 0, 0, 0);
              const bf16x8 a1 = *(const bf16x8*)(AC + (32 * rt + r32) * 168 + 112 + 16 * ks + 8 * hi);
              const bf16x8 b1 = *(const bf16x8*)(KI + (64 + 32 * ct + r32) * 56 + 16 * ks + 8 * hi);
              ab = __builtin_amdgcn_mfma_f32_32x32x16_bf16(a1, b1, ab, 0, 0, 0); }
          const int j = 32 * ct + r32;
#pragma unroll
          for (int r = 0; r < 16; ++r) { const int i = 32 * rt + (r & 3) + 8 * (r >> 2) + 4 * hi;
              const float val = ((j <= i) ? af[r] : 0.f) + ((j >= i) ? ab[r] : 0.f);
              AC[i * 168 + j] = (bf16)(cvtpk(val, val) & 0xffffu); } }
        const int fr = lane & 15, fq = lane >> 4;
        unsigned short gpre[4][6];
#pragma unroll
        for (int r = 0; r < 4; ++r)
#pragma unroll
            for (int ct = 0; ct < 6; ++ct) gpre[r][ct] = P[(size_t)(rowbase + 16 * w4 + 4 * fq + r) * INP + C_GG + h * 96 + 16 * ct + fr];
        __syncthreads();
        if (next_pair >= 0) gla_prefetch(pz0, pz1, pw0, pw1, kp, l, next_pair, lane, wave);
        f32x4 o6[6];
#pragma unroll
        for (int ct = 0; ct < 6; ++ct) o6[ct] = (f32x4){0.f, 0.f, 0.f, 0.f};
        { const int q4 = fr >> 2, p4 = lane & 3;
#pragma unroll
          for (int ks = 0; ks < 2; ++ks) {
              const bf16x8 a = *(const bf16x8*)(AC + (16 * w4 + fr) * 168 + 32 * ks + 8 * fq);
#pragma unroll
              for (int ct = 0; ct < 6; ++ct) { const bf16x8 bb = tr8(Vr + (32 * ks + 8 * fq + q4) * 104 + 16 * ct + 4 * p4, 4 * 104);
                  o6[ct] = __builtin_amdgcn_mfma_f32_16x16x32_bf16(a, bb, o6[ct], 0, 0, 0); } }
#pragma unroll
          for (int ks = 2; ks < 5; ++ks) {
              const bf16x8 a = *(const bf16x8*)(AC + (16 * w4 + fr) * 168 + 32 * ks + 8 * fq);
#pragma unroll
              for (int ct = 0; ct < 6; ++ct) { const bf16x8 bb = tr8(SB + (32 * (ks - 2) + 8 * fq + q4) * 104 + 16 * ct + 4 * p4, 4 * 104);
                  o6[ct] = __builtin_amdgcn_mfma_f32_16x16x32_bf16(a, bb, o6[ct], 0, 0, 0); } } }
        bf16* MIX = (bf16*)(kp.ws() + WS_MIX);
        const float* gng = kp.in(I_GNG) + l * 96;
        float gn6[6];
#pragma unroll
        for (int ct = 0; ct < 6; ++ct) gn6[ct] = gng[16 * ct + fr];
#pragma unroll
        for (int r = 0; r < 4; ++r) { float ssq = 0.f;
#pragma unroll
            for (int ct = 0; ct < 6; ++ct) ssq += o6[ct][r] * o6[ct][r];
            ssq = row16_sum(ssq);
            const float rstd = 1.0f / sqrtf(ssq * (1.f / 96.f) + EPS);
            const int i = 16 * w4 + 4 * fq + r;
#pragma unroll
            for (int ct = 0; ct < 6; ++ct) MIX[(size_t)(rowbase + i) * D + h * 96 + 16 * ct + fr] = (bf16)f2bf(o6[ct][r] * rstd * gn6[ct] * silu_f(bf2f(gpre[r][ct]))); }
    }
}

__device__ __forceinline__ void prep_pool_item(const KPD& kp, int l, int sc, unsigned char* lds, int tid, int lane, int wave) {
    int b, n, rowbase; chunk_coords(sc, b, n, rowbase);
    const bool isctx = sc >= 512; const int s0 = isctx ? (n - 128) * 64 : n * 64; const int T = isctx ? CTXL : SEQ;
    bf16* P = (bf16*)(kp.ws() + WS_P);
    {
      const int sub = tid & 7, t = tid >> 3;
      const int fb = 8 * (sub & 1);
      const bool isx2 = (sub & 2) != 0;
      float cn[8], sn[8];
      if (!isctx) { const int sp = s0 + t; const float pos = (float)((sub >> 2) ? (sp & 63) : (sp >> 6));
#pragma unroll
          for (int i = 0; i < 8; ++i) { const float inv = exp2f(-(float)(fb + i) * (13.287712379549449f / 16.f));
              const float rev = pos * inv * 0.15915494309189535f; const float fr_ = rev - floorf(rev);
              sn[i] = __builtin_amdgcn_sinf(fr_); cn[i] = __builtin_amdgcn_cosf(fr_); if (!isx2) sn[i] = -sn[i]; } }
      else {
#pragma unroll
          for (int i = 0; i < 8; ++i) { cn[i] = 1.f; sn[i] = 0.f; } }
      bf16* prow_ = P + (size_t)(rowbase + t) * INP + 8 * sub;
      v4u vin[8];
#pragma unroll
      for (int hd = 0; hd < 8; ++hd) vin[hd] = *(const v4u*)(prow_ + (hd < 6 ? C_AQ + hd * 64 : C_AK + (hd - 6) * 64));
      const f32x4 gq0 = *(const f32x4*)(kp.in(I_QNG) + l * 64 + 8 * sub), gq1 = *(const f32x4*)(kp.in(I_QNG) + l * 64 + 8 * sub + 4);
      const f32x4 gk0 = *(const f32x4*)(kp.in(I_KNG) + l * 64 + 8 * sub), gk1 = *(const f32x4*)(kp.in(I_KNG) + l * 64 + 8 * sub + 4);
#pragma unroll
      for (int hd = 0; hd < 8; ++hd) {
          const f32x4 g0 = hd < 6 ? gq0 : gk0, g1 = hd < 6 ? gq1 : gk1;
          const float osc = hd < 6 ? 0.18033688011112042f : 1.0f;
          const v4u v = vin[hd];
          float x[8] = {lo16(v.x), hi16(v.x), lo16(v.y), hi16(v.y), lo16(v.z), hi16(v.z), lo16(v.w), hi16(v.w)};
          float ss = 0.f;
#pragma unroll
          for (int i = 0; i < 8; ++i) ss += x[i] * x[i];
          ss += __shfl_xor(ss, 1); ss += __shfl_xor(ss, 2); ss += __shfl_xor(ss, 4);
          const float rstd = 1.0f / sqrtf(ss * (1.f / 64.f) + EPS);
          x[0] *= rstd * g0.x; x[1] *= rstd * g0.y; x[2] *= rstd * g0.z; x[3] *= rstd * g0.w; x[4] *= rstd * g1.x; x[5] *= rstd * g1.y; x[6] *= rstd * g1.z; x[7] *= rstd * g1.w;
          if (!isctx) {
#pragma unroll
              for (int i = 0; i < 8; ++i) { const float other = __shfl_xor(x[i], 2); x[i] = x[i] * cn[i] + other * sn[i]; } }
          v4u o; o.x = pk2(x[0] * osc, x[1] * osc); o.y = pk2(x[2] * osc, x[3] * osc); o.z = pk2(x[4] * osc, x[5] * osc); o.w = pk2(x[6] * osc, x[7] * osc);
          *(v4u*)(prow_ + (hd < 6 ? C_AQ + hd * 64 : C_AK + (hd - 6) * 64)) = o; } }
    if (isctx && l != 0) return;
    bf16* AP = (bf16*)lds;
    const bf16* WT = (const bf16*)(kp.ws() + WS_PWT) + (size_t)l * 4 * 64 * 64;
    { const int t = tid >> 3, cgp = tid & 7, g = cgp >> 1, w2 = 1 << g  ; const int s = s0 + t;
      const int lo = max(s - w2, 0), hi = min(s + w2, T);
      const int cb = C_PU + g * 64 + (cgp & 1) * 32;
      float acc[32];
#pragma unroll
      for (int i = 0; i < 32; ++i) acc[i] = 0.f;
      for (int j = lo; j < hi; ++j) { const bf16* up = P + (size_t)(rowbase + j - s0) * INP + cb;
#pragma unroll
          for (int q = 0; q < 4; ++q) { const v4u v = *(const v4u*)(up + 8 * q);
              acc[8 * q] += lo16(v.x); acc[8 * q + 1] += hi16(v.x); acc[8 * q + 2] += lo16(v.y); acc[8 * q + 3] += hi16(v.y); acc[8 * q + 4] += lo16(v.z); acc[8 * q + 5] += hi16(v.z); acc[8 * q + 6] += lo16(v.w); acc[8 * q + 7] += hi16(v.w); } }
      const float rc = 1.0f / (float)(hi - lo);
      const bf16* up = P + (size_t)(rowbase + t) * INP + cb;
#pragma unroll
      for (int q = 0; q < 4; ++q) { const v4u v = *(const v4u*)(up + 8 * q);
          v4u o; o.x = pk2(acc[8 * q] * rc - lo16(v.x), acc[8 * q + 1] * rc - hi16(v.x)); o.y = pk2(acc[8 * q + 2] * rc - lo16(v.y), acc[8 * q + 3] * rc - hi16(v.y));
          o.z = pk2(acc[8 * q + 4] * rc - lo16(v.z), acc[8 * q + 5] * rc - hi16(v.z)); o.w = pk2(acc[8 * q + 6] * rc - lo16(v.w), acc[8 * q + 7] * rc - hi16(v.w));
          *(v4u*)(AP + (g * 64 + t) * 72 + (cgp & 1) * 32 + 8 * q) = o; } }
    __syncthreads();
    bf16* MIX = (bf16*)(kp.ws() + WS_MIX);
    const float* psc = kp.in(I_POOLS) + l * 256;
    const int r32 = lane & 31, hi = lane >> 5;
#pragma unroll
    for (int tt = 0; tt < 2; ++tt) { const int tile = wave * 2 + tt, g = tile >> 2, rt = (tile >> 1) & 1, ct = tile & 1;
        f32x16 acc;
#pragma unroll
        for (int r = 0; r < 16; ++r) acc[r] = 0.f;
#pragma unroll
        for (int ks = 0; ks < 4; ++ks) {
            const bf16x8 a = *(const bf16x8*)(AP + (g * 64 + 32 * rt + r32) * 72 + 16 * ks + 8 * hi);
            const bf16x8 bb = *(const bf16x8*)(WT + (g * 64 + 32 * ct + r32) * 64 + 16 * ks + 8 * hi);
            acc = __builtin_amdgcn_mfma_f32_32x32x16_bf16(a, bb, acc, 0, 0, 0); }
        const int nn = 32 * ct + r32; const float scl = psc[g * 64 + nn];
#pragma unroll
        for (int r = 0; r < 16; ++r) { const int i = 32 * rt + (r & 3) + 8 * (r >> 2) + 4 * hi;
            MIX[(size_t)(rowbase + i) * D + 768 + g * 64 + nn] = (bf16)f2bf(acc[r] * scl); } }
}
__device__ __forceinline__ void gla_scan(const KPD& kp, int tid) {
    if (tid >= 288) return;
    const int gid = blockIdx.x * 288 + tid;
    if (gid >= 2 * 4 * 9216) return;
    const int e2 = gid % 9216, db = gid / 9216, dir = db >> 2, elem = 2 * e2, h = elem / 4608, d = (elem % 4608) / 96;
    const bf16* ST = (const bf16*)(kp.ws() + WS_ST) + (size_t)db * NCH * 18432 + elem;
    bf16* SI = (bf16*)(kp.ws() + WS_SI) + (size_t)db * NCH * 18432 + elem;
    const float* DEC = (const float*)(kp.ws() + WS_DEC) + (size_t)db * NCH * 192 + h * 48 + d;
    f32x2 s = {0.f, 0.f};
#pragma unroll 1
    for (int s0 = 0; s0 < NCH; s0 += 22) {
        unsigned cs[22]; float dc[22];
#pragma unroll
        for (int u = 0; u < 22; ++u) { const int step = s0 + u; const int n = dir ? (131 - step) : (step < 4 ? 128 + step : step - 4);
            cs[u] = *(const unsigned*)(ST + (size_t)n * 18432); dc[u] = DEC[n * 192]; }
#pragma unroll
        for (int u = 0; u < 22; ++u) { const int step = s0 + u; const int n = dir ? (131 - step) : (step < 4 ? 128 + step : step - 4);
            *(unsigned*)(SI + (size_t)n * 18432) = pk2(s.x, s.y); s = dc[u] * s + (f32x2){lo16(cs[u]), hi16(cs[u])}; }
    }
}

__device__ __forceinline__ void swa_item(const KPD& kp, int l, int item, unsigned char* lds, int tid, int lane, int wave) {
    const bool isctx = item >= 512;
    int b, qblk, kvh, qrow0;
    if (!isctx) { kvh = item & 1; qblk = (item >> 1) & 63; b = item >> 7; qrow0 = b * SEQ + qblk * 128; }
    else { const int j = item - 512; kvh = j & 1; qblk = (j >> 1) & 1; b = j >> 2; qrow0 = MLAT + b * CTXL + qblk * 128; }
    const bf16* P = (const bf16*)(kp.ws() + WS_P);
    bf16* Kt = (bf16*)lds;
    bf16* Vs = (bf16*)(lds + 18432);
    const int fr = lane & 15, fq = lane >> 4;
    bf16x8 qf[3][2];
#pragma unroll
    for (int hh = 0; hh < 3; ++hh)
#pragma unroll
        for (int ks = 0; ks < 2; ++ks) qf[hh][ks] = *(const bf16x8*)(P + (size_t)(qrow0 + 16 * wave + fr) * INP + C_AQ + (kvh * 3 + hh) * 64 + 32 * ks + 8 * fq);
    float mrow[3], lrow[3]; f32x4 O[3][4];
#pragma unroll
    for (int hh = 0; hh < 3; ++hh) { mrow[hh] = kp.in(I_SINK)[l * 6 + kvh * 3 + hh] * 1.4426950408889634f; lrow[hh] = (fq == 0) ? 1.f : 0.f;
#pragma unroll
        for (int dt = 0; dt < 4; ++dt) O[hh][dt] = (f32x4){0.f, 0.f, 0.f, 0.f}; }
    int nt = 0; int krow[5]; int kmode[5];
#pragma unroll
    for (int kt = 0; kt < 5; ++kt) { krow[kt] = 0; kmode[kt] = 0; }
    int t0 = 0;
    if (!isctx) {
        if (qblk > 0) { krow[0] = b * SEQ + (qblk - 1) * 128; kmode[0] = 1; t0 = 1; }
    }
    const bool hasprev = !isctx && qblk > 0, hascur = !isctx, hasnext = !isctx && qblk < 63;
    const int s_prev = 0, s_next = hasprev ? 1 : 0, s_cur = s_next + (hasnext ? 1 : 0), s_c0 = s_cur + (hascur ? 1 : 0), s_c1 = s_c0 + 1;
    nt = s_c1 + 1;
    (void)t0; (void)s_prev;
    auto tile_row = [&](int i) -> int {
        if (hasprev && i == 0) return b * SEQ + (qblk - 1) * 128;
        if (hasnext && i == s_next) return b * SEQ + (qblk + 1) * 128;
        if (hascur && i == s_cur) return b * SEQ + qblk * 128;
        if (i == s_c0) return MLAT + b * CTXL;
        return MLAT + b * CTXL + 128; };
    auto tile_mode = [&](int i) -> int { if (hasprev && i == 0) return 1; if (hasnext && i == s_next) return 2; return 0; };
    v4u kpre[4], vpre2[4];
    const int nstage = (nt + 1) >> 1;
#define SWA_LOAD_STAGE(ST) do { _Pragma("unroll") for (int slot = 0; slot < 2; ++slot) if (2 * (ST) + slot < nt) { const int kr = tile_row(2 * (ST) + slot); \
        _Pragma("unroll") for (int i = 0; i < 2; ++i) { const int idx = tid + 512 * i, key = idx >> 3, c8 = idx & 7; const bf16* src = P + (size_t)(kr + key) * INP + kvh * 64 + 8 * c8; \
            kpre[2 * slot + i] = *(const v4u*)(src + C_AK); vpre2[2 * slot + i] = *(const v4u*)(src + C_AV); } } } while (0)
    SWA_LOAD_STAGE(0);
    const int q4 = (lane & 15) >> 2, p4 = lane & 3;
#pragma unroll 1
    for (int st = 0; st < nstage; ++st) {
        const int ta = 2 * st, ntl = (nt - ta) < 2 ? (nt - ta) : 2;
        __syncthreads();
#pragma unroll
        for (int slot = 0; slot < 2; ++slot) if (slot < ntl) {
#pragma unroll
            for (int i = 0; i < 2; ++i) { const int idx = tid + 512 * i, key = idx >> 3, c8 = idx & 7;
                *(v4u*)(Kt + slot * 18432 + key * 72 + 8 * c8) = kpre[2 * slot + i]; *(v4u*)(Vs + slot * 18432 + key * 72 + 8 * c8) = vpre2[2 * slot + i]; } }
        if (st + 1 < nstage) SWA_LOAD_STAGE(st + 1);
        __syncthreads();
#pragma unroll 1
        for (int h2 = 0; h2 < 2 * ntl; ++h2) {
            const int slot = h2 >> 1, half = h2 & 1, mode = tile_mode(ta + slot);
            const bf16* Ktt = Kt + slot * 18432; const bf16* Vss = Vs + slot * 18432;
            if ((mode == 1 && half == 0 && wave >= 4) || (mode == 2 && half == 1 && wave <= 3)) continue;
            f32x4 S[3][4];
#pragma unroll
            for (int ct = 0; ct < 4; ++ct) {
#pragma unroll
                for (int hh = 0; hh < 3; ++hh) S[hh][ct] = (f32x4){0.f, 0.f, 0.f, 0.f};
#pragma unroll
                for (int ks = 0; ks < 2; ++ks) { const bf16x8 kf = *(const bf16x8*)(Ktt + (64 * half + 16 * ct + fr) * 72 + 32 * ks + 8 * fq);
#pragma unroll
                    for (int hh = 0; hh < 3; ++hh) S[hh][ct] = __builtin_amdgcn_mfma_f32_16x16x32_bf16(kf, qf[hh][ks], S[hh][ct], 0, 0, 0); } }
            if (mode != 0) {
                const int qi = 16 * wave + fr;
#pragma unroll
                for (int ct = 0; ct < 4; ++ct)
#pragma unroll
                    for (int r = 0; r < 4; ++r) { const int key = 64 * half + 16 * ct + 4 * fq + r;
                        const bool bad = (mode == 1) ? (key < qi) : (key > qi);
                        if (bad) { S[0][ct][r] = -1e30f; S[1][ct][r] = -1e30f; S[2][ct][r] = -1e30f; } }
            }
            bf16x8 pf[3][2];
#pragma unroll
            for (int hh = 0; hh < 3; ++hh) {
                float mx = fmaxf(fmaxf(S[hh][0][0], S[hh][0][1]), fmaxf(S[hh][0][2], S[hh][0][3]));
#pragma unroll
                for (int ct = 1; ct < 4; ++ct) mx = fmaxf(mx, fmaxf(fmaxf(S[hh][ct][0], S[hh][ct][1]), fmaxf(S[hh][ct][2], S[hh][ct][3])));
                mx = pg8::xor16_32_max(mx);
                float mnew = mrow[hh];
                const bool resc = __builtin_amdgcn_ballot_w64(mx > mrow[hh] + 8.0f) != 0ull;
                if (resc) { mnew = fmaxf(mrow[hh], mx); const float alpha = __builtin_amdgcn_exp2f(mrow[hh] - mnew); lrow[hh] *= alpha;
#pragma unroll
                    for (int dt = 0; dt < 4; ++dt) O[hh][dt] *= alpha; }
                float rs = 0.f; unsigned pw[8];
#pragma unroll
                for (int ct = 0; ct < 4; ++ct) { const float p0 = __builtin_amdgcn_exp2f(S[hh][ct][0] - mnew), p1 = __builtin_amdgcn_exp2f(S[hh][ct][1] - mnew), p2 = __builtin_amdgcn_exp2f(S[hh][ct][2] - mnew), p3 = __builtin_amdgcn_exp2f(S[hh][ct][3] - mnew);
                    rs += (p0 + p1) + (p2 + p3); pw[2 * ct] = cvtpk_b(p0, p1); pw[2 * ct + 1] = cvtpk_b(p2, p3); }
                lrow[hh] += rs; mrow[hh] = mnew;
                pf[hh][0] = __builtin_bit_cast(bf16x8, (v4u){pw[0], pw[1], pw[2], pw[3]});
                pf[hh][1] = __builtin_bit_cast(bf16x8, (v4u){pw[4], pw[5], pw[6], pw[7]});
            }
#pragma unroll
            for (int c2 = 0; c2 < 2; ++c2)
#pragma unroll
                for (int dt = 0; dt < 4; ++dt) {
                    const __attribute__((address_space(3))) bf16* vp = (const __attribute__((address_space(3))) bf16*)Vss + (64 * half + 32 * c2 + 4 * fq + q4) * 72 + 16 * dt + 4 * p4;
                    const v4i16_t lo = __builtin_amdgcn_ds_read_tr16_b64_v4i16((__attribute__((address_space(3))) v4i16_t*)vp);
                    const v4i16_t hi = __builtin_amdgcn_ds_read_tr16_b64_v4i16((__attribute__((address_space(3))) v4i16_t*)(vp + 16 * 72));
                    const bf16x8 vf = (bf16x8){lo[0], lo[1], lo[2], lo[3], hi[0], hi[1], hi[2], hi[3]};
#pragma unroll
                    for (int hh = 0; hh < 3; ++hh) O[hh][dt] = __builtin_amdgcn_mfma_f32_16x16x32_bf16(vf, pf[hh][c2], O[hh][dt], 0, 0, 0); }
        }
    }
#undef SWA_LOAD_STAGE
    bf16* MIX = (bf16*)(kp.ws() + WS_MIX);
#pragma unroll
    for (int hh = 0; hh < 3; ++hh) { float lt = lrow[hh];
        lt = pg8::xor16_32_sum(lt);
        const float inv = 1.0f / lt;
        bf16* o = MIX + (size_t)(qrow0 + 16 * wave + fr) * D + 384 + (kvh * 3 + hh) * 64 + 4 * fq;
#pragma unroll
        for (int dt = 0; dt < 4; ++dt) *(v2u*)(o + 16 * dt) = (v2u){cvtpk(O[hh][dt][0] * inv, O[hh][dt][1] * inv), cvtpk(O[hh][dt][2] * inv, O[hh][dt][3] * inv)}; }
}

__device__ __forceinline__ void act_pass(const KPD& kp, int l, const bf16* U, bf16* ACT, int nrows, int T, int tid) {
    const float* cw = kp.in(I_CONVW) + (size_t)l * 3 * DFF2; const float* cb = kp.in(I_CONVB) + (size_t)l * DFF2;
    const int total = nrows * 352;
    for (int idx = blockIdx.x * 512 + tid; idx < total; idx += gridDim.x * 512) {
        const int row = idx / 352, c = (idx % 352) * 8, t = row % T;
        float a[8], g[8];
#pragma unroll
        for (int i = 0; i < 8; ++i) { a[i] = cb[c + i]; g[i] = cb[DFF + c + i]; }
#pragma unroll
        for (int j = 0; j < 3; ++j) { const int tt = t + j - 1; if (tt < 0 || tt >= T) continue;
            const bf16* ur = U + (size_t)(row + j - 1) * DFF2 + c;
            const v4u ua = *(const v4u*)ur, ug = *(const v4u*)(ur + DFF);
            const float* wa = cw + j * DFF2 + c; const float* wg = wa + DFF;
            const float xa[8] = {lo16(ua.x), hi16(ua.x), lo16(ua.y), hi16(ua.y), lo16(ua.z), hi16(ua.z), lo16(ua.w), hi16(ua.w)};
            const float xg[8] = {lo16(ug.x), hi16(ug.x), lo16(ug.y), hi16(ug.y), lo16(ug.z), hi16(ug.z), lo16(ug.w), hi16(ug.w)};
#pragma unroll
            for (int i = 0; i < 8; ++i) { a[i] += wa[i] * xa[i]; g[i] += wg[i] * xg[i]; } }
        v4u o; o.x = pk2(silu_f(g[0]) * a[0], silu_f(g[1]) * a[1]); o.y = pk2(silu_f(g[2]) * a[2], silu_f(g[3]) * a[3]);
        o.z = pk2(silu_f(g[4]) * a[4], silu_f(g[5]) * a[5]); o.w = pk2(silu_f(g[6]) * a[6], silu_f(g[7]) * a[7]);
        *(v4u*)(ACT + (size_t)row * DFF + c) = o;
    }
}

#define LAS __attribute__((address_space(3)))
#define XB_TMO      128
#define XB_XCNT(j)  (256  + 64 * (j))
#define XB_XSUB(j)  (1280 + 64 * (j))
#define XB_XGEN(j)  (2304 + 64 * (j))
#define XB_TOP      3328
#define XB_TOPGEN   3392
#define XCD_BAR_WORDS 3456
#define XB_SPIN_CAP (1u << 18)

__device__ __forceinline__ unsigned xb_ld(unsigned* p)              { return __hip_atomic_load(p, __ATOMIC_RELAXED, __HIP_MEMORY_SCOPE_AGENT); }
__device__ __forceinline__ unsigned xb_add(unsigned* p, unsigned v) { return __hip_atomic_fetch_add(p, v, __ATOMIC_RELAXED, __HIP_MEMORY_SCOPE_AGENT); }
__device__ __forceinline__ unsigned xb_xcc_id() { return (unsigned)__builtin_amdgcn_s_getreg((3 << 11) | 20) & 0xFu; }
#define XB_SPIN(cond, bar) do { unsigned _sp = 0; while (cond) { __builtin_amdgcn_s_sleep(1); \
    if ((++_sp & 255u) == 0u) { if (xb_ld(&(bar)[XB_TMO])) break; if (_sp > XB_SPIN_CAP) { atomicAdd(&(bar)[XB_TMO], 1u); break; } } } } while (0)

struct XcdBarrier {
    unsigned* bar; unsigned x;
    volatile LAS unsigned* st;
};

__device__ __forceinline__ XcdBarrier xcd_barrier_post(unsigned* bar, volatile LAS unsigned* st) {
    XcdBarrier b; b.bar = bar; b.x = xb_xcc_id(); b.st = st;
    if (threadIdx.x == 0) (void)xb_add(&bar[XB_XCNT(b.x)], 1u);
    return b;
}
__device__ __forceinline__ void xcd_barrier_complete(unsigned* bar, unsigned x, unsigned& nloc, unsigned& nx) {
    const unsigned G = gridDim.x * gridDim.y * gridDim.z;
    unsigned sum, cnt, mine, sp = 0u;
    for (;;) {
        sum = 0u; cnt = 0u; mine = 0u;
#pragma unroll
        for (unsigned j = 0; j < 16; ++j) { const unsigned c = xb_ld(&bar[XB_XCNT(j)]); sum += c; cnt += (c > 0u) ? 1u : 0u; mine = (j == x) ? c : mine; }
        if (sum == G) break;
        __builtin_amdgcn_s_sleep(1);
        if ((++sp & 255u) == 0u) { if (xb_ld(&bar[XB_TMO])) break; if (sp > XB_SPIN_CAP) { atomicAdd(&bar[XB_TMO], 1u); break; } }
    }
    nloc = mine > 0u ? mine : 1u; nx = cnt > 0u ? cnt : 1u;
}

__device__ __forceinline__ void xcd_barrier(const XcdBarrier& b) {
    asm volatile("s_waitcnt vmcnt(0)" ::: "memory");
    __syncthreads();
    if (threadIdx.x == 0) {
        unsigned* bar = b.bar;
        __builtin_amdgcn_s_waitcnt(0);
        unsigned nloc = b.st[0], nx = b.st[1];
        if (nloc == 0u) { xcd_barrier_complete(bar, b.x, nloc, nx); b.st[0] = nloc; b.st[1] = nx; }
        const unsigned old = xb_add(&bar[XB_XSUB(b.x)], 1u);
        const unsigned gen = old / nloc;
        if (old + 1u == (gen + 1u) * nloc) {
            __builtin_amdgcn_fence(__ATOMIC_RELEASE, "agent");
            asm volatile("s_waitcnt vmcnt(0)" ::: "memory");
            const unsigned og = xb_add(&bar[XB_TOP], 1u);
            const unsigned tg = og / nx;
            if (og + 1u == (tg + 1u) * nx) xb_add(&bar[XB_TOPGEN], 1u);
            else XB_SPIN(xb_ld(&bar[XB_TOPGEN]) == tg, bar);
            __builtin_amdgcn_fence(__ATOMIC_ACQUIRE, "agent");
            xb_add(&bar[XB_XGEN(b.x)], 1u);
            asm volatile("s_waitcnt vmcnt(0)" ::: "memory");
        } else {
            XB_SPIN(xb_ld(&bar[XB_XGEN(b.x)]) == gen, bar);
            __builtin_amdgcn_fence(__ATOMIC_ACQUIRE, "agent");
            asm volatile("s_waitcnt vmcnt(0)" ::: "memory");
        }
    }
    __syncthreads();
}

__global__ void __launch_bounds__(512, 2) fwd_kernel(KP kparg) {
    extern __shared__ __attribute__((aligned(16))) unsigned char lds[];
    int tid = threadIdx.x, lane = tid & 63, wave = __builtin_amdgcn_readfirstlane(tid >> 6);
#define XITEM(it) (((it) & ~255) + (c & 7) * 32 + (c >> 3))
#define FRESH() do { tid = threadIdx.x; asm volatile("" : "+v"(tid)); lane = tid & 63; wave = __builtin_amdgcn_readfirstlane(tid >> 6); } while (0)
    if (tid == 0) { unsigned long long* tb = (unsigned long long*)(lds + PTAB_OFF);
#pragma unroll
        for (int i = 0; i < 22; ++i) tb[i] = (unsigned long long)kparg.in[i];
        tb[22] = (unsigned long long)kparg.out; tb[23] = (unsigned long long)kparg.ws; }
    __syncthreads();
    if (tid < 64) ((unsigned*)(lds + CTRL_OFF))[tid] = 0u;
    __syncthreads();
    KPD kp{lds};
    unsigned char* ws = kp.ws();
    PG8_LAS unsigned char* ldsg = (PG8_LAS unsigned char*)lds;
    bf16* H = (bf16*)(ws + WS_H); bf16* Pm = (bf16*)(ws + WS_P); bf16* MIX = (bf16*)(ws + WS_MIX); bf16* ACT = (bf16*)(ws + WS_ACT);
    float* CTXB = (float*)(ws + WS_CTX);
    const int G = gridDim.x, c = blockIdx.x;

    (void)xcd_barrier_post((unsigned*)ws + 1024, (volatile LAS unsigned*)(lds + CTRL_OFF) + 8);
#define GRIDBAR() do { XcdBarrier b_; b_.bar = (unsigned*)kp.ws() + 1024; b_.x = xb_xcc_id(); b_.st = (volatile LAS unsigned*)(lds + CTRL_OFF) + 8; xcd_barrier(b_); } while (0)
#ifndef NO_PRO
    prologue<0>(kp, lds, tid, lane, wave); __syncthreads();
#endif
    GRIDBAR();
#pragma unroll 1
    for (int l = 0; l < 2; ++l) {
        const float* mod = (const float*)(ws + WS_MOD) + (size_t)l * 5 * 6144;
        const float* xin = l ? kp.out() : kp.in(I_X); const float* cin = l ? CTXB : kp.in(I_CTX);
        FRESH();
#ifndef NO_PRO
        if (l == 0) { prologue<1>(kp, lds, tid, lane, wave); }
#endif
        for (int rep = 0; rep < REP_NORM; ++rep)
        norm_pass(xin, cin, H, kp.in(I_N1G) + l * D, mod, 0, 1024, MALL, lane, wave, l ? (const float*)(ws + WS_PART) : nullptr, CTXB);
        GRIDBAR();
        { pg8::Gemm g{H, (const bf16*)(ws + WS_WIN) + (size_t)l * INP * D, MALL, INP, D}; pg8::StaticOrder S; S.init(MALL, INP, G, c);
          pg8::EpiBf16S E{Pm, INP, INW};
#ifndef NO_G1
          for (int rep = 0; rep < REP_GEMM; ++rep)
          pg8::gemm_phase<pg8::EpiBf16S, pg8::StaticOrder, true, true>(ldsg, g, S, E);
#endif
        }
        GRIDBAR();
        FRESH();
        v4u gz0 = {0u, 0u, 0u, 0u}, gz1 = gz0, gw0 = gz0, gw1 = gz0; { const int i0 = (G == 256) ? XITEM(c) : c; if (i0 < 1056) gla_prefetch(gz0, gz1, gw0, gw1, kp, l, i0, lane, wave); }
        for (int it = c; it < 1056 + 528 + 255; it += G) { const int item = (G == 256) ? XITEM(it) : it; if (item >= 1056 + 528) break;
#ifndef NO_GLAA
            if (item < 1056) { const int nx = (G == 256) ? XITEM(it + G) : it + G; gla_pair<false>(kp, l, item, lds, tid, lane, wave, gz0, gz1, gw0, gw1, nx < 1056 ? nx : -1); __syncthreads(); }
#endif
#ifndef NO_PREP
            if (item >= 1056) prep_pool_item(kp, l, item - 1056, lds, tid, lane, wave);
#endif
            __syncthreads();
        }
        GRIDBAR();
        FRESH();
        gla_scan(kp, tid);
        {
#ifndef NO_SWA
          for (int rep = 0; rep < REP_SWA; ++rep)
          for (int it = c; it < 512; it += G) { const int item = (G == 256) ? XITEM(it) : it; swa_item(kp, l, item, lds, tid, lane, wave); __syncthreads(); }
#endif
        }
        GRIDBAR();
        FRESH();
        { const int ngl = l ? 1024 : 1056;
#ifndef NO_GLAC
          v4u gz0 = {0u, 0u, 0u, 0u}, gz1 = gz0, gw0 = gz0, gw1 = gz0; { const int i0 = (G == 256) ? XITEM(c) : c; if (i0 < ngl) gla_prefetch(gz0, gz1, gw0, gw1, kp, l, i0, lane, wave); }
          for (int it = c; it < ngl + 255; it += G) { const int item = (G == 256) ? XITEM(it) : it; if (item >= ngl) break;
              const int nx = (G == 256) ? XITEM(it + G) : it + G; gla_pair<true>(kp, l, item, lds, tid, lane, wave, gz0, gz1, gw0, gw1, nx < ngl ? nx : -1); __syncthreads(); }
#endif
          if (l == 0) { const int v = (G == 256) ? ((c & 7) * 32 + (c >> 3)) : c; const int j = (G == 256) ? v - 32 : (c < 16 ? c : -1);
              if (j >= 0 && j < 16) { swa_item(kp, l, 512 + j, lds, tid, lane, wave); __syncthreads(); } }
        }
        GRIDBAR();
        const int M2 = l ? MLAT : MALL;
        { pg8::Gemm g{MIX, (const bf16*)(ws + WS_WOUT) + (size_t)l * D * D, MLAT, D, D}; pg8::StaticOrder S; S.init(MLAT, D, G, c);
          pg8::EpiRes E{xin, cin, kp.out(), CTXB, mod + 2048};
#ifndef NO_G2
          pg8::gemm_phase<pg8::EpiRes, pg8::StaticOrder, true, true>(ldsg, g, S, E);
#endif
        }
        if (l == 0 && c < 64) { const int j = c >> 2, sl = c & 3;
            pg8::Gemm g{MIX + (size_t)MLAT * D + sl * 256, (const bf16*)(ws + WS_WOUT) + sl * 256, MCTX, D, 256, D}; pg8::OneUnit S{j >> 2, j & 3};
            pg8::EpiPart E{(float*)(ws + WS_PART) + (size_t)sl * MCTX * D, mod + 2048 + 4 * 6144};
            pg8::gemm_phase<pg8::EpiPart, pg8::OneUnit, true, true>(ldsg, g, S, E); }
        GRIDBAR();
        FRESH();
        for (int rep = 0; rep < REP_NORM; ++rep)
        norm_pass(kp.out(), CTXB, H, kp.in(I_N2G) + l * D, mod, 3072, 4096, M2, lane, wave, l ? nullptr : (const float*)(ws + WS_PART), CTXB);
        GRIDBAR();
        { const int nMt = l ? 132 : 136;
          pg8::Gemm g{H, (const bf16*)(ws + WS_WUP) + (size_t)l * DFF2 * D, nMt * 256, DFF2, D}; pg8::ConvOrder S; S.init(nMt * 256, DFF2, G, c);
          pg8::EpiConv E{ACT, kp.in(I_CONVW) + (size_t)l * 3 * DFF2, kp.in(I_CONVB) + (size_t)l * DFF2, (PG8_LAS float*)(ldsg + XB_OFF)};
#ifndef NO_G3
          for (int rep = 0; rep < REP_GEMM; ++rep)
          pg8::gemm_phase<pg8::EpiConv, pg8::ConvOrder, true, true>(ldsg, g, S, E);
#endif
        }
        GRIDBAR();
        { pg8::Gemm g{ACT, (const bf16*)(ws + WS_WDN) + (size_t)l * D * DFF, MLAT, D, DFF}; pg8::StaticOrder S; S.init(MLAT, D, G, c);
          pg8::EpiRes E{kp.out(), CTXB, kp.out(), CTXB, mod + 5120};
#ifndef NO_G4
          pg8::gemm_phase<pg8::EpiRes, pg8::StaticOrder, true, true>(ldsg, g, S, E);
#endif
        }
        if (l == 0 && c < 64) { const int j = c >> 2, sl = c & 3; const int k0 = (sl == 0 ? 0 : sl == 1 ? 12 : sl == 2 ? 24 : 34) * 64, kl = (sl < 2 ? 12 : 10) * 64;
            pg8::Gemm g{ACT + (size_t)MLAT * DFF + k0, (const bf16*)(ws + WS_WDN) + k0, MCTX, D, kl, DFF}; pg8::OneUnit S{j >> 2, j & 3};
            pg8::EpiPart E{(float*)(ws + WS_PART) + (size_t)sl * MCTX * D, mod + 5120 + 4 * 6144};
            pg8::gemm_phase<pg8::EpiPart, pg8::OneUnit, true, true>(ldsg, g, S, E); }
        GRIDBAR();
    }
}

extern "C" void kernel_launch(void* const* d_in, const int* in_sizes, int n_in, void* d_out, int out_size, void* d_ws, size_t ws_size, hipStream_t stream) {
    static int grid = 0;
    if (grid == 0) {
        if (n_in != 22 || ws_size < WS_END) { fprintf(stderr, "kernel_launch: unexpected n_in %d / ws %zu\n", n_in, ws_size); grid = -1; return; }
        int dev = 0, cus = 0, per_cu = 0;
        hipGetDevice(&dev); hipDeviceGetAttribute(&cus, hipDeviceAttributeMultiprocessorCount, dev);
        hipFuncSetAttribute((const void*)fwd_kernel, hipFuncAttributeMaxDynamicSharedMemorySize, LDS_BYTES);
        hipOccupancyMaxActiveBlocksPerMultiprocessor(&per_cu, (const void*)fwd_kernel, 512, LDS_BYTES);
        if (per_cu < 1) { fprintf(stderr, "kernel_launch: occupancy query says %d blocks per CU\n", per_cu); per_cu = 1; }
        grid = cus * 1;
    }
    if (grid < 0) return;
    (void)hipMemsetAsync(d_ws, 0, 65536, stream);
    KP kp{};
    for (int i = 0; i < 22; ++i) kp.in[i] = (const float*)d_in[i];
    kp.out = (float*)d_out; kp.ws = (unsigned char*)d_ws;
    void* args[] = {&kp};
    hipError_t e = hipLaunchCooperativeKernel((const void*)fwd_kernel, dim3(grid), dim3(512), args, LDS_BYTES, stream);
    if (e != hipSuccess) fprintf(stderr, "cooperative launch failed: %s (grid %d)\n", hipGetErrorString(e), grid);
}
```
